# Optimizing an MI355X kernel written in HIP

```python
import math
import jax, jax.numpy as jnp
from jax import lax
import numpy as np

D_MODEL = 2048
BATCH = 2
SEQ = 8192
DEPTH = 4
DEC_BATCH = 1
DEC_SEQ = 16384
PAST_LEN = 128

N_META = 16
N_MIXERS = 2
N_S5_LAYERS = (DEPTH + 1) // 2
N_ATTN_LAYERS = DEPTH // 2
D_FF = 5632
S5_GROUP = 16
S5_GROUPS = D_MODEL // S5_GROUP
S5_STATE = 64
HEAD_DIM = 128
N_Q_HEADS = D_MODEL // HEAD_DIM
N_KV_HEADS = 4
Q_PER_KV = N_Q_HEADS // N_KV_HEADS
WINDOW = 128
BLOCK = 128
ROPE_THETA = 10000.0
RMS_EPS = 1e-6
DT_MIN = 1e-3
DT_MAX = 1e-1

kernel_name = "hybrid_s5_swa_macaron_encoder"


def rmsnorm(x, g):
    xf = x.astype(jnp.float32)
    inv = lax.rsqrt(jnp.mean(xf * xf, axis=-1, keepdims=True) + RMS_EPS)
    return (xf * inv * g.astype(jnp.float32)).astype(x.dtype)


def swiglu(x, w_gate, w_up, w_down):
    return (jax.nn.silu(x @ w_gate) * (x @ w_up)) @ w_down


def rope(x, pos):
    half = HEAD_DIM // 2
    inv_freq = jnp.power(jnp.float32(ROPE_THETA), -jnp.arange(half, dtype=jnp.float32) / half)
    ang = pos.astype(jnp.float32)[:, None] * inv_freq[None, :]
    cos = jnp.cos(ang)[None, :, None, :]
    sin = jnp.sin(ang)[None, :, None, :]
    xf = x.astype(jnp.float32)
    x1, x2 = xf[..., :half], xf[..., half:]
    return jnp.concatenate([x1 * cos - x2 * sin, x2 * cos + x1 * sin], axis=-1).astype(x.dtype)


def windowed_sink_attention(h, w_qkv, w_o, sink):
    B, L, _ = h.shape
    qkv = h @ w_qkv
    q, k, v = jnp.split(qkv, [N_Q_HEADS * HEAD_DIM, (N_Q_HEADS + N_KV_HEADS) * HEAD_DIM], axis=-1)
    q = q.reshape(B, L, N_Q_HEADS, HEAD_DIM)
    k = k.reshape(B, L, N_KV_HEADS, HEAD_DIM)
    v = v.reshape(B, L, N_KV_HEADS, HEAD_DIM)
    pos = jnp.arange(L)
    q = rope(q, pos)
    k = rope(k, pos)
    k_meta, v_meta = k[:, :N_META], v[:, :N_META]
    lead = BLOCK - N_META
    tail = (-(L + lead)) % BLOCK
    padw = ((0, 0), (lead, tail), (0, 0), (0, 0))
    qp, kp, vp = jnp.pad(q, padw), jnp.pad(k, padw), jnp.pad(v, padw)
    Lp = L + lead + tail
    nb = Lp // BLOCK
    qb = qp.reshape(B, nb, BLOCK, N_KV_HEADS, Q_PER_KV, HEAD_DIM)
    kb = jnp.pad(kp.reshape(B, nb, BLOCK, N_KV_HEADS, HEAD_DIM), ((0, 0), (1, 1), (0, 0), (0, 0), (0, 0)))
    vb = jnp.pad(vp.reshape(B, nb, BLOCK, N_KV_HEADS, HEAD_DIM), ((0, 0), (1, 1), (0, 0), (0, 0), (0, 0)))
    k_band = jnp.concatenate([kb[:, :-2], kb[:, 1:-1], kb[:, 2:]], axis=2)
    v_band = jnp.concatenate([vb[:, :-2], vb[:, 1:-1], vb[:, 2:]], axis=2)
    blk = jnp.arange(nb)
    q_pos = blk[:, None] * BLOCK + jnp.arange(BLOCK)[None, :] - lead
    k_pos = (blk[:, None] - 1) * BLOCK + jnp.arange(3 * BLOCK)[None, :] - lead
    band_ok = ((jnp.abs(q_pos[:, :, None] - k_pos[:, None, :]) <= WINDOW)
               & (k_pos[:, None, :] >= N_META) & (k_pos[:, None, :] < L))
    scale = HEAD_DIM ** -0.5
    s_band = jnp.einsum("bnqhgd,bnkhd->bnhgqk", qb, k_band).astype(jnp.float32) * scale
    s_band = jnp.where(band_ok[None, :, None, None], s_band, -jnp.inf)
    s_meta = jnp.einsum("bnqhgd,bmhd->bnhgqm", qb, k_meta).astype(jnp.float32) * scale
    sink_l = sink.astype(jnp.float32).reshape(N_KV_HEADS, Q_PER_KV)[None, None, :, :, None, None]
    m = jnp.maximum(jnp.maximum(jnp.max(s_band, axis=-1, keepdims=True),
                                jnp.max(s_meta, axis=-1, keepdims=True)), sink_l)
    p_band = jnp.exp(s_band - m)
    p_meta = jnp.exp(s_meta - m)
    denom = jnp.sum(p_band, axis=-1, keepdims=True) + jnp.sum(p_meta, axis=-1, keepdims=True) + jnp.exp(sink_l - m)
    inv = 1.0 / denom
    o = (jnp.einsum("bnhgqk,bnkhd->bnqhgd", p_band * inv, v_band.astype(jnp.float32))
         + jnp.einsum("bnhgqm,bmhd->bnqhgd", p_meta * inv, v_meta.astype(jnp.float32)))
    o = o.reshape(B, Lp, N_Q_HEADS * HEAD_DIM)[:, lead:lead + L].astype(h.dtype)
    return o @ w_o


def _linear_combine(left, right):
    a_l, b_l = left
    a_r, b_r = right
    return a_r * a_l, a_r * b_l + b_r


def s5_mixer(h, a_re, a_im, log_dt, b_re, b_im, c_re, c_im, d, w_glu):
    B, L, _ = h.shape
    hf = h.astype(jnp.float32)
    u = hf.reshape(B, L, S5_GROUPS, S5_GROUP)
    lam = lax.complex(a_re.astype(jnp.float32), a_im.astype(jnp.float32))
    dt = jnp.exp(log_dt.astype(jnp.float32))[..., None]
    a_bar = jnp.exp(lam * dt)
    b_c = lax.complex(b_re.astype(jnp.float32), b_im.astype(jnp.float32))
    b_bar = ((a_bar - 1.0) / lam)[..., None] * b_c
    c_c = lax.complex(c_re.astype(jnp.float32), c_im.astype(jnp.float32))
    y = d.astype(jnp.float32) * hf
    for direction, rev in ((0, False), (1, True)):
        bu = jnp.einsum("blgh,gph->blgp", u, b_bar[direction])
        a_seq = jnp.broadcast_to(a_bar[direction][None, None], (1, L, S5_GROUPS, S5_STATE))
        _, states = lax.associative_scan(_linear_combine, (a_seq, bu), reverse=rev, axis=1)
        y = y + jnp.real(jnp.einsum("blgp,ghp->blgh", states, c_c[direction])).reshape(B, L, D_MODEL)
    z = jax.nn.gelu(y).astype(h.dtype)
    return (z @ w_glu[0]) * jax.nn.sigmoid(z @ w_glu[1])


def trunk(x, meta_tokens, norm_gains, final_norm, ffn_w_gate, ffn_w_up, ffn_w_down,
          s5_a_re, s5_a_im, s5_log_dt, s5_b_re, s5_b_im, s5_c_re, s5_c_im, s5_d, s5_glu_w,
          attn_w_qkv, attn_w_o, attn_sink):
    B = x.shape[0]
    meta = jnp.broadcast_to(meta_tokens.astype(x.dtype)[None], (B, N_META, D_MODEL))
    h = jnp.concatenate([meta, x], axis=1)
    for i in range(DEPTH):
        g = norm_gains[i]
        h = h + 0.5 * swiglu(rmsnorm(h, g[0]), ffn_w_gate[i, 0], ffn_w_up[i, 0], ffn_w_down[i, 0])
        j = i // N_MIXERS
        if i % N_MIXERS == 0:
            h = h + s5_mixer(rmsnorm(h, g[1]), s5_a_re[j], s5_a_im[j], s5_log_dt[j], s5_b_re[j], s5_b_im[j],
                             s5_c_re[j], s5_c_im[j], s5_d[j], s5_glu_w[j])
        else:
            h = h + windowed_sink_attention(rmsnorm(h, g[1]), attn_w_qkv[j], attn_w_o[j], attn_sink[j])
        h = h + 0.5 * swiglu(rmsnorm(h, g[2]), ffn_w_gate[i, 1], ffn_w_up[i, 1], ffn_w_down[i, 1])
    return rmsnorm(h, final_norm)[:, N_META:]


def setup_inputs(seed: int = 0) -> dict:
    key = jax.random.key(seed)
    ks = jax.random.split(key, 24)
    f32 = jnp.float32

    def nrm(k, shape, scale):
        return jax.random.normal(k, shape, f32) * scale

    G, P, H = S5_GROUPS, S5_STATE, S5_GROUP
    n_idx = jnp.arange(P, dtype=f32)
    x_prompt = nrm(ks[0], (BATCH, SEQ, D_MODEL), 1.0)
    x_sample = nrm(ks[1], (DEC_BATCH, DEC_SEQ, D_MODEL), 1.0)
    meta_tokens = nrm(ks[2], (N_META, D_MODEL), 1.0)
    norm_gains = 1.0 + nrm(ks[3], (DEPTH, 3, D_MODEL), 0.02)
    final_norm = 1.0 + nrm(ks[4], (D_MODEL,), 0.02)
    ffn_w_gate = nrm(ks[5], (DEPTH, 2, D_MODEL, D_FF), D_MODEL ** -0.5)
    ffn_w_up = nrm(ks[6], (DEPTH, 2, D_MODEL, D_FF), D_MODEL ** -0.5)
    ffn_w_down = nrm(ks[7], (DEPTH, 2, D_FF, D_MODEL), D_FF ** -0.5)
    s5_a_re = -0.5 + nrm(ks[8], (N_S5_LAYERS, 2, G, P), 0.01)
    s5_a_im = math.pi * n_idx + nrm(ks[9], (N_S5_LAYERS, 2, G, P), 0.01)
    s5_log_dt = jax.random.uniform(ks[10], (N_S5_LAYERS, 2, G), f32, math.log(DT_MIN), math.log(DT_MAX))
    s5_b_re = nrm(ks[11], (N_S5_LAYERS, 2, G, P, H), (2.0 * H) ** -0.5)
    s5_b_im = nrm(ks[12], (N_S5_LAYERS, 2, G, P, H), (2.0 * H) ** -0.5)
    s5_c_re = nrm(ks[13], (N_S5_LAYERS, 2, G, H, P), 0.5)
    s5_c_im = nrm(ks[14], (N_S5_LAYERS, 2, G, H, P), 0.5)
    s5_d = nrm(ks[15], (N_S5_LAYERS, D_MODEL), 1.0)
    s5_glu_w = nrm(ks[16], (N_S5_LAYERS, 2, D_MODEL, D_MODEL), D_MODEL ** -0.5)
    attn_w_qkv = nrm(ks[17], (N_ATTN_LAYERS, D_MODEL, (N_Q_HEADS + 2 * N_KV_HEADS) * HEAD_DIM), D_MODEL ** -0.5)
    attn_w_o = nrm(ks[18], (N_ATTN_LAYERS, N_Q_HEADS * HEAD_DIM, D_MODEL), (N_Q_HEADS * HEAD_DIM) ** -0.5)
    attn_sink = nrm(ks[19], (N_ATTN_LAYERS, N_Q_HEADS), 0.5)
    return {"x_prompt": x_prompt, "x_sample": x_sample, "meta_tokens": meta_tokens,
            "norm_gains": norm_gains, "final_norm": final_norm,
            "ffn_w_gate": ffn_w_gate, "ffn_w_up": ffn_w_up, "ffn_w_down": ffn_w_down,
            "s5_a_re": s5_a_re, "s5_a_im": s5_a_im, "s5_log_dt": s5_log_dt,
            "s5_b_re": s5_b_re, "s5_b_im": s5_b_im, "s5_c_re": s5_c_re, "s5_c_im": s5_c_im,
            "s5_d": s5_d, "s5_glu_w": s5_glu_w,
            "attn_w_qkv": attn_w_qkv, "attn_w_o": attn_w_o, "attn_sink": attn_sink}


def reference(x_prompt, x_sample, meta_tokens, norm_gains, final_norm, ffn_w_gate, ffn_w_up, ffn_w_down,
              s5_a_re, s5_a_im, s5_log_dt, s5_b_re, s5_b_im, s5_c_re, s5_c_im, s5_d, s5_glu_w,
              attn_w_qkv, attn_w_o, attn_sink):
    y_prompt = trunk(x_prompt, meta_tokens, norm_gains, final_norm, ffn_w_gate, ffn_w_up, ffn_w_down,
                     s5_a_re, s5_a_im, s5_log_dt, s5_b_re, s5_b_im, s5_c_re, s5_c_im, s5_d, s5_glu_w,
                     attn_w_qkv, attn_w_o, attn_sink)
    y_sample = trunk(x_sample, meta_tokens, norm_gains, final_norm, ffn_w_gate, ffn_w_up, ffn_w_down,
                     s5_a_re, s5_a_im, s5_log_dt, s5_b_re, s5_b_im, s5_c_re, s5_c_im, s5_d, s5_glu_w,
                     attn_w_qkv, attn_w_o, attn_sink)
    return (y_prompt, y_sample)
```

```cpp
#include <hip/hip_runtime.h>
#include <cstdio>
#include <cstdint>

#define LAS __attribute__((address_space(3)))
typedef unsigned short bf16_t;
typedef short bf16x8 __attribute__((ext_vector_type(8)));
typedef float f32x4 __attribute__((ext_vector_type(4)));
typedef float f32x2 __attribute__((ext_vector_type(2)));
typedef float f32x16 __attribute__((ext_vector_type(16)));
typedef unsigned u32x4 __attribute__((ext_vector_type(4)));
typedef unsigned u32x2 __attribute__((ext_vector_type(2)));

constexpr int D = 2048, DFF = 5632, NREAL = 32768, MVALID = 32816, MPAD = 33024;
constexpr int NG = 128, NCH = 2051, NCHP = 2304;
constexpr int QKLD = 2560;
constexpr float RMS_EPS = 1e-6f;
constexpr float LOG2E = 1.4426950408889634f;

constexpr size_t MiB = 1u << 20;
constexpr size_t WS_CTL = 0, CTL_BYTES = 1 * MiB;
constexpr size_t WS_ROPE = 1 * MiB;
constexpr size_t ROPE_HALF = (size_t)16400 * 64 * 4;
constexpr size_t WS_SS = 10 * MiB;
constexpr size_t WS_A16 = 13 * MiB;
constexpr size_t WS_H = 14 * MiB;
constexpr size_t WS_HB = 272 * MiB;
constexpr size_t WS_ACT = 401 * MiB;
constexpr size_t WS_VT = WS_ACT + 162 * MiB;
constexpr size_t WS_R2 = 756 * MiB;
constexpr size_t WS_W = 1044 * MiB;
constexpr size_t WS_WGU_A = WS_W, WS_WD_A = WS_W + 44 * MiB, WS_WGU_B = WS_W + 66 * MiB, WS_WD_B = WS_W + 110 * MiB, WS_WMIX = WS_W + 132 * MiB;
constexpr size_t WS_S5T = WS_W + 196 * MiB;
constexpr size_t S5T_PW_L = (size_t)NG * 2 * 64 * 17 * 2, S5T_BB_L = (size_t)NG * 2 * 64 * 16 * 2, S5T_BB_OFF = 2 * S5T_PW_L;
constexpr size_t WS_END = WS_S5T + 10 * MiB;
constexpr size_t MIX_WGLU = 0, MIX_BMAT = 16 * MiB, MIX_WY = 32 * MiB;
constexpr size_t MIX_WQK = 0, MIX_WVT = 10 * MiB, MIX_WO = 12 * MiB;

constexpr int RING_BYTES = 131072, RED_OFF = 131072, MISC_OFF = 131072 + 4096, LDS_BYTES = 147456;

__device__ __forceinline__ unsigned cvt_pk_bf16(float lo, float hi) { unsigned r; asm volatile("v_cvt_pk_bf16_f32 %0, %1, %2" : "=v"(r) : "v"(lo), "v"(hi)); return r; }
__device__ __forceinline__ float fast_exp2(float x) { return __builtin_amdgcn_exp2f(x); }
__device__ __forceinline__ float fast_rcp(float x) { return __builtin_amdgcn_rcpf(x); }
__device__ __forceinline__ float sigmoidf_(float x) { return fast_rcp(1.0f + fast_exp2(-x * LOG2E)); }
__device__ __forceinline__ float wave_sum(float v) {
#pragma unroll
    for (int o = 1; o < 64; o <<= 1) v += __shfl_xor(v, o);
    return v;
}
__device__ __forceinline__ float row_inv(const float* ss, int row, int nparts) {
    const f32x4* p = (const f32x4*)(ss + (size_t)row * 16);
    f32x4 a = p[0], b = p[1];
    float s = (a.x + a.y) + (a.z + a.w) + (b.x + b.y) + (b.z + b.w);
    if (nparts > 8) { f32x4 c = p[2], d = p[3]; s += (c.x + c.y) + (c.z + c.w) + (d.x + d.y) + (d.z + d.w); }
    return rsqrtf(s * (1.0f / D) + RMS_EPS);
}
__device__ __forceinline__ int chunk_tok_row(int cr, int t) {
    const int s = cr >= 1026 ? 2 : (cr >= 513 ? 1 : 0);
    const int c = cr - (s == 2 ? 1026 : (s == 1 ? 513 : 0));
    const int rb = s == 2 ? 16384 : (s == 1 ? 8192 : 0);
    return c == 0 ? NREAL + 16 * s + t : rb + (c - 1) * 16 + t;
}
__device__ __forceinline__ int row_pos(int r) {
    if (r >= NREAL) return (r - NREAL) & 15;
    const int rb = r >= 16384 ? 16384 : (r >= 8192 ? 8192 : 0);
    return 16 + r - rb;
}

#define XB_TMO      128
#define XB_XCNT(j)  (256  + 64 * (j))
#define XB_XSUB(j)  (1280 + 64 * (j))
#define XB_XGEN(j)  (2304 + 64 * (j))
#define XB_TOP      3328
#define XB_TOPGEN   3392
#define XCD_BAR_WORDS 3456
#define XB_SPIN_CAP (1u << 20)

__device__ __forceinline__ unsigned xb_ld(unsigned* p)              { return __hip_atomic_load(p, __ATOMIC_RELAXED, __HIP_MEMORY_SCOPE_AGENT); }
__device__ __forceinline__ unsigned xb_add(unsigned* p, unsigned v) { return __hip_atomic_fetch_add(p, v, __ATOMIC_RELAXED, __HIP_MEMORY_SCOPE_AGENT); }
__device__ __forceinline__ unsigned xb_xcc_id() { return (unsigned)__builtin_amdgcn_s_getreg((3 << 11) | 20) & 0xFu; }
#define XB_SPIN(cond, bar) do { unsigned _sp = 0; while (cond) { __builtin_amdgcn_s_sleep(1); \
    if ((++_sp & 255u) == 0u) { if (xb_ld(&(bar)[XB_TMO])) break; if (_sp > XB_SPIN_CAP) { atomicAdd(&(bar)[XB_TMO], 1u); break; } } } } while (0)

struct XcdBarrier { unsigned* bar; unsigned x; volatile LAS unsigned* st; };

__device__ __forceinline__ XcdBarrier xcd_barrier_post(unsigned* bar, volatile LAS unsigned* st) {
    XcdBarrier b; b.bar = bar; b.x = xb_xcc_id(); b.st = st;
    if (threadIdx.x == 0) (void)xb_add(&bar[XB_XCNT(b.x)], 1u);
    return b;
}
__device__ __forceinline__ void xcd_barrier_complete(unsigned* bar, unsigned x, unsigned& nloc, unsigned& nx) {
    const unsigned G = gridDim.x * gridDim.y * gridDim.z;
    unsigned sum, cnt, mine, sp = 0u;
    for (;;) {
        sum = 0u; cnt = 0u; mine = 0u;
#pragma unroll
        for (unsigned j = 0; j < 16; ++j) { const unsigned c = xb_ld(&bar[XB_XCNT(j)]); sum += c; cnt += (c > 0u) ? 1u : 0u; mine = (j == x) ? c : mine; }
        if (sum == G) break;
        __builtin_amdgcn_s_sleep(1);
        if ((++sp & 255u) == 0u) { if (xb_ld(&bar[XB_TMO])) break; if (sp > XB_SPIN_CAP) { atomicAdd(&bar[XB_TMO], 1u); break; } }
    }
    nloc = mine > 0u ? mine : 1u; nx = cnt > 0u ? cnt : 1u;
}
__device__ __forceinline__ void xcd_barrier(const XcdBarrier& b) {
    asm volatile("s_waitcnt vmcnt(0)" ::: "memory");
    __syncthreads();
    if (threadIdx.x == 0) {
        unsigned* bar = b.bar;
        __builtin_amdgcn_s_waitcnt(0);
        unsigned nloc = b.st[0], nx = b.st[1];
        if (nloc == 0u) { xcd_barrier_complete(bar, b.x, nloc, nx); b.st[0] = nloc; b.st[1] = nx; }
        const unsigned old = xb_add(&bar[XB_XSUB(b.x)], 1u);
        const unsigned gen = old / nloc;
        if (old + 1u == (gen + 1u) * nloc) {
            __builtin_amdgcn_fence(__ATOMIC_RELEASE, "agent");
            asm volatile("s_waitcnt vmcnt(0)" ::: "memory");
            const unsigned og = xb_add(&bar[XB_TOP], 1u);
            const unsigned tg = og / nx;
            if (og + 1u == (tg + 1u) * nx) xb_add(&bar[XB_TOPGEN], 1u);
            else XB_SPIN(xb_ld(&bar[XB_TOPGEN]) == tg, bar);
            __builtin_amdgcn_fence(__ATOMIC_ACQUIRE, "agent");
            xb_add(&bar[XB_XGEN(b.x)], 1u);
            asm volatile("s_waitcnt vmcnt(0)" ::: "memory");
        } else {
            XB_SPIN(xb_ld(&bar[XB_XGEN(b.x)]) == gen, bar);
            __builtin_amdgcn_fence(__ATOMIC_ACQUIRE, "agent");
            asm volatile("s_waitcnt vmcnt(0)" ::: "memory");
        }
    }
    __syncthreads();
}

namespace pg8 {
constexpr int BM = 256, BK = 64, HALF = 128, HTB = HALF * BK * 2, STAGE_BYTES = 8 * HTB, NXCD = 8, WGM = 8;
__host__ __device__ __forceinline__ int lds_byte(int r, int c) { const int st = (r >> 4) * 2 + (c >> 5), rr = r & 15, cc = c & 31, ob = rr * 64 + cc * 2; return st * 1024 + (ob ^ (((ob >> 9) & 1) << 5)); }
__host__ __device__ __forceinline__ void stage_rc(int b, int& R, int& C) { const int st = b / 1024, sb = b % 1024, swz = sb ^ (((sb >> 9) & 1) << 5); R = (st >> 1) * 16 + swz / 64; C = (st & 1) * 32 + (swz % 64) / 2; }
__host__ __device__ __forceinline__ int perm32(int rho) { const int n = rho >> 4, i = rho & 15; return 8 * (i >> 2) + 4 * n + (i & 3); }

struct Unit { int pm, pn; };
struct Gemm { const bf16_t* A; const bf16_t* Bt; int lda, ldb, K; };

struct StaticOrder {
    int nM, nN, nwg, G, c;
    __device__ void init(int M, int N, int G_, int c_) { nM = M / BM; nN = N / BM; nwg = nM * nN; G = G_; c = c_; }
    __device__ bool next(int i, Unit& u) const {
        const long L = (long)i * G + c; if (L >= nwg) return false;
        int wgid = (int)L; { const int q = nwg / NXCD, r = nwg % NXCD, xcd = wgid % NXCD, off = wgid / NXCD; wgid = (xcd < r ? xcd * (q + 1) : r * (q + 1) + (xcd - r) * q) + off; }
        const int nig = WGM * nN, gid = wgid / nig, fm = gid * WGM, gsz = (nM - fm) < WGM ? (nM - fm) : WGM;
        u.pm = fm + ((wgid % nig) % gsz); u.pn = (wgid % nig) / gsz; return true;
    }
};
struct BlockDiagOrder {
    int nwg, G, c;
    __device__ void init(int G_, int c_) { nwg = NG * 9; G = G_; c = c_; }
    __device__ bool next(int i, Unit& u) const { const int L = i * G + c; if (L >= nwg) return false; u.pm = L; u.pn = L / 9; return true; }
};

template <class Epi, class Sched>
__device__ __forceinline__ void gemm_phase(LAS unsigned char* lds, const Gemm g, const Sched& S, const Epi& E) {
    const int K = g.K, nt = K / BK;
    const int wid = __builtin_amdgcn_readfirstlane((int)threadIdx.x >> 6), wr = wid >> 2;
    unsigned voffA[2], voffB[2]; int aoff, boff;
#define PG8_LANE_SETUP() do { int t_ = threadIdx.x; asm volatile("" : "+v"(t_)); const int l_ = t_ & 63, w_ = __builtin_amdgcn_readfirstlane(t_ >> 6); \
        _Pragma("unroll") for (int i = 0; i < 2; ++i) { int R, C; stage_rc(t_ * 16 + i * 8192, R, C); const int Rb = Epi::PERM ? ((R & ~31) + perm32(R & 31)) : R; \
            voffA[i] = (unsigned)(R * g.lda + C) * 2u; voffB[i] = (unsigned)(Rb * g.ldb + C) * 2u; } \
        aoff = lds_byte((w_ >> 2) * 64 + (l_ & 15), (l_ >> 4) * 8); boff = lds_byte((w_ & 3) * 32 + (l_ & 15), (l_ >> 4) * 8); } while (0)
    PG8_LANE_SETUP();
    const size_t kstep = (size_t)(BK * 2);
    const size_t hstepA = (size_t)HALF * g.lda * 2, hstepB = (size_t)HALF * g.ldb * 2;
    const size_t tstepA = 2 * hstepA, tstepB = 2 * hstepB;
    const unsigned ldsw = (unsigned)wid * 1024u;
#define PG8_SA(b, h) (((b) * 2 + (h)) * HTB)
#define PG8_SB(b, h) ((4 + (b) * 2 + (h)) * HTB)
#define PG8_STAGE(bufoff, gbase, voff) do { _Pragma("unroll") for (int _i = 0; _i < 2; ++_i) \
        __builtin_amdgcn_global_load_lds((const unsigned*)((const char*)(gbase) + (voff)[_i]), (LAS unsigned*)(lds + (bufoff) + ldsw + _i * 8192), 16, 0, 0); } while (0)
#define PG8_LDA(dst, b, h) do { _Pragma("unroll") for (int m = 0; m < 4; ++m) _Pragma("unroll") for (int k = 0; k < 2; ++k) dst[m][k] = *(const LAS bf16x8*)(lds + PG8_SA(b, h) + aoff + m * 2048 + k * 1024); } while (0)
#define PG8_LDB(dst, b, h) do { _Pragma("unroll") for (int n = 0; n < 2; ++n) _Pragma("unroll") for (int k = 0; k < 2; ++k) dst[n][k] = *(const LAS bf16x8*)(lds + PG8_SB(b, h) + boff + n * 2048 + k * 1024); } while (0)
#define PG8_MMA(ai, bj, At, Bt) do { __builtin_amdgcn_s_setprio(1); _Pragma("unroll") for (int m = 0; m < 4; ++m) _Pragma("unroll") for (int n = 0; n < 2; ++n) _Pragma("unroll") for (int k = 0; k < 2; ++k) \
        acc[ai][bj][m][n] = __builtin_amdgcn_mfma_f32_16x16x32_bf16(Bt[n][k], At[m][k], acc[ai][bj][m][n], 0, 0, 0); __builtin_amdgcn_s_setprio(0); } while (0)
#define PG8_WAIT_V(n) asm volatile("s_waitcnt vmcnt(" #n ")" ::: "memory")
#define PG8_WAIT_L(n) asm volatile("s_waitcnt lgkmcnt(" #n ")" ::: "memory")
#define PG8_BAR __builtin_amdgcn_s_barrier()
#define PG8_SCHED __builtin_amdgcn_sched_barrier(0)
    Unit cur, nxt; int ui = 0;
    if (!S.next(0, cur)) return;
    f32x4 acc[2][2][4][2];
#pragma unroll
    for (int a = 0; a < 2; ++a)
#pragma unroll
        for (int b = 0; b < 2; ++b)
#pragma unroll
            for (int m = 0; m < 4; ++m)
#pragma unroll
                for (int n = 0; n < 2; ++n) acc[a][b][m][n] = (f32x4){0.f, 0.f, 0.f, 0.f};
    bf16x8 At[4][2], B0[2][2], B1[2][2];
    const char* cA = (const char*)g.A + (size_t)cur.pm * tstepA; const char* cB = (const char*)g.Bt + (size_t)cur.pn * tstepB;
    PG8_STAGE(PG8_SB(0, 0), cB, voffB); PG8_STAGE(PG8_SB(0, 1), cB + hstepB, voffB); PG8_STAGE(PG8_SA(0, 0), cA, voffA); PG8_STAGE(PG8_SA(0, 1), cA + hstepA, voffA);
    if (wr == 1) PG8_BAR;
    PG8_WAIT_V(2); PG8_BAR;
    PG8_STAGE(PG8_SB(1, 0), cB + kstep, voffB); PG8_STAGE(PG8_SA(1, 0), cA + kstep, voffA); PG8_STAGE(PG8_SB(1, 1), cB + hstepB + kstep, voffB);
    PG8_WAIT_V(6); PG8_BAR;
    for (;;) {
        const bool has_next = S.next(ui + 1, nxt);
        const char* nA = has_next ? (const char*)g.A + (size_t)nxt.pm * tstepA : cA; const char* nB = has_next ? (const char*)g.Bt + (size_t)nxt.pn * tstepB : cB;
        for (int t = 0; t < nt; t += 2) {
            const bool last = (t == nt - 2);
            const char* a1 = cA + (size_t)(t + 1) * kstep;
            const char* a2 = last ? nA : cA + (size_t)(t + 2) * kstep; const char* b2 = last ? nB : cB + (size_t)(t + 2) * kstep;
            const char* a3 = a2 + kstep; const char* b3 = b2 + kstep;
            PG8_LDB(B0, 0, 0); PG8_LDB(B1, 0, 1); PG8_SCHED; PG8_LDA(At, 0, 0); PG8_STAGE(PG8_SA(1, 1), a1 + hstepA, voffA);
            PG8_WAIT_V(8); PG8_WAIT_L(0); PG8_BAR; PG8_MMA(0, 0, At, B0); PG8_MMA(0, 1, At, B1); PG8_BAR; PG8_SCHED;
            PG8_LDA(At, 0, 1); PG8_STAGE(PG8_SB(0, 0), b2, voffB); PG8_STAGE(PG8_SB(0, 1), b2 + hstepB, voffB); PG8_STAGE(PG8_SA(0, 0), a2, voffA);
            PG8_WAIT_V(8); PG8_WAIT_L(0); PG8_BAR; PG8_MMA(1, 0, At, B0); PG8_MMA(1, 1, At, B1); PG8_BAR; PG8_SCHED;
            PG8_LDB(B0, 1, 0); PG8_LDB(B1, 1, 1); PG8_SCHED; PG8_LDA(At, 1, 0); PG8_STAGE(PG8_SA(0, 1), a2 + hstepA, voffA);
            PG8_WAIT_V(8); PG8_WAIT_L(0); PG8_BAR; PG8_MMA(0, 0, At, B0); PG8_MMA(0, 1, At, B1); PG8_BAR; PG8_SCHED;
            PG8_LDA(At, 1, 1); PG8_STAGE(PG8_SB(1, 0), b3, voffB); PG8_STAGE(PG8_SB(1, 1), b3 + hstepB, voffB); PG8_STAGE(PG8_SA(1, 0), a3, voffA);
            PG8_WAIT_V(8); PG8_WAIT_L(0); PG8_BAR; PG8_MMA(1, 0, At, B0); PG8_MMA(1, 1, At, B1); PG8_BAR; PG8_SCHED;
        }
        if (wr == 0) PG8_BAR;
        { int t_ = threadIdx.x; asm volatile("" : "+v"(t_)); const int l_ = t_ & 63, w_ = __builtin_amdgcn_readfirstlane(t_ >> 6);
          E(acc, cur, w_ >> 2, w_ & 3, l_ & 15, l_ >> 4); }
        if (!has_next) break;
        PG8_LANE_SETUP();
#pragma unroll
        for (int a = 0; a < 2; ++a)
#pragma unroll
            for (int b = 0; b < 2; ++b)
#pragma unroll
                for (int m = 0; m < 4; ++m)
#pragma unroll
                    for (int n = 0; n < 2; ++n) acc[a][b][m][n] = (f32x4){0.f, 0.f, 0.f, 0.f};
        cur = nxt; cA = nA; cB = nB; ++ui;
        if (wr == 1) PG8_BAR;
    }
    PG8_WAIT_V(0);
    PG8_BAR;
#undef PG8_LANE_SETUP
#undef PG8_SA
#undef PG8_SB
#undef PG8_STAGE
#undef PG8_LDA
#undef PG8_LDB
#undef PG8_MMA
#undef PG8_WAIT_V
#undef PG8_WAIT_L
#undef PG8_BAR
#undef PG8_SCHED
}
}
using pg8::Unit;


struct EpiSwiGLU {
    static constexpr bool PERM = true;
    bf16_t* act; const float* ss; int nparts;
    __device__ __forceinline__ void operator()(const f32x4 (&acc)[2][2][4][2], const Unit& u, int wr, int wc, int fr, int fq) const {
        const int row0 = u.pm * 256 + wr * 64 + fr, col0 = u.pn * 128 + wc * 32 + 8 * fq;
#pragma unroll
        for (int ai = 0; ai < 2; ++ai)
#pragma unroll
            for (int m = 0; m < 4; ++m) {
                const int r = row0 + ai * 128 + m * 16; const float inv = row_inv(ss, r, nparts);
                float o[8];
#pragma unroll
                for (int n = 0; n < 2; ++n)
#pragma unroll
                    for (int j = 0; j < 4; ++j) { const float gt = acc[ai][0][m][n][j] * inv, up = acc[ai][1][m][n][j] * inv; o[n * 4 + j] = gt * sigmoidf_(gt) * up; }
                u32x4 w; w.x = cvt_pk_bf16(o[0], o[1]); w.y = cvt_pk_bf16(o[2], o[3]); w.z = cvt_pk_bf16(o[4], o[5]); w.w = cvt_pk_bf16(o[6], o[7]);
                *(u32x4*)(act + (size_t)r * DFF + col0) = w;
            }
    }
};

struct EpiResid {
    static constexpr bool PERM = true;
    float* h; bf16_t* hb; float* ss; float scale; LAS float* red;
    __device__ __forceinline__ void operator()(const f32x4 (&acc)[2][2][4][2], const Unit& u, int wr, int wc, int fr, int fq) const {
        const int row0 = u.pm * 256 + wr * 64 + fr, col0 = u.pn * 256 + wc * 32 + 8 * fq;
        float rs[2][4];
#pragma unroll
        for (int ai = 0; ai < 2; ++ai)
#pragma unroll
            for (int m = 0; m < 4; ++m) {
                const size_t r = (size_t)(row0 + ai * 128 + m * 16); float* hp = h + r * D + col0; bf16_t* bp = hb + r * D + col0; float s = 0.f;
#pragma unroll
                for (int bj = 0; bj < 2; ++bj) {
                    f32x4 v0 = *(const f32x4*)(hp + bj * 128), v1 = *(const f32x4*)(hp + bj * 128 + 4);
                    v0 += scale * acc[ai][bj][m][0]; v1 += scale * acc[ai][bj][m][1];
                    *(f32x4*)(hp + bj * 128) = v0; *(f32x4*)(hp + bj * 128 + 4) = v1;
                    u32x4 w; w.x = cvt_pk_bf16(v0[0], v0[1]); w.y = cvt_pk_bf16(v0[2], v0[3]); w.z = cvt_pk_bf16(v1[0], v1[1]); w.w = cvt_pk_bf16(v1[2], v1[3]);
                    *(u32x4*)(bp + bj * 128) = w;
                    s += (v0[0] * v0[0] + v0[1] * v0[1]) + (v0[2] * v0[2] + v0[3] * v0[3]) + (v1[0] * v1[0] + v1[1] * v1[1]) + (v1[2] * v1[2] + v1[3] * v1[3]);
                }
                rs[ai][m] = s;
            }
#pragma unroll
        for (int ai = 0; ai < 2; ++ai)
#pragma unroll
            for (int m = 0; m < 4; ++m) { float s = rs[ai][m]; s += __shfl_xor(s, 16); s += __shfl_xor(s, 32); if (fq == 0) red[(ai * 128 + wr * 64 + m * 16 + fr) * 4 + wc] = s; }
        asm volatile("s_waitcnt lgkmcnt(0)" ::: "memory"); __builtin_amdgcn_s_barrier(); asm volatile("" ::: "memory");
        const int tid = threadIdx.x;
        if (tid < 256) { const f32x4 v = *(const LAS f32x4*)(red + tid * 4); ss[(size_t)(u.pm * 256 + tid) * 16 + u.pn] = (v.x + v.y) + (v.z + v.w); }
    }
};

struct EpiGLU {
    static constexpr bool PERM = true;
    float* h; bf16_t* hb; float* ss; LAS float* red;
    __device__ __forceinline__ void operator()(const f32x4 (&acc)[2][2][4][2], const Unit& u, int wr, int wc, int fr, int fq) const {
        const int row0 = u.pm * 256 + wr * 64 + fr, col0 = u.pn * 128 + wc * 32 + 8 * fq;
        float rs[2][4];
#pragma unroll
        for (int ai = 0; ai < 2; ++ai)
#pragma unroll
            for (int m = 0; m < 4; ++m) {
                const size_t r = (size_t)(row0 + ai * 128 + m * 16); float* hp = h + r * D + col0; bf16_t* bp = hb + r * D + col0;
                f32x4 v0 = *(const f32x4*)(hp), v1 = *(const f32x4*)(hp + 4);
#pragma unroll
                for (int j = 0; j < 4; ++j) { v0[j] += acc[ai][0][m][0][j] * sigmoidf_(acc[ai][1][m][0][j]); v1[j] += acc[ai][0][m][1][j] * sigmoidf_(acc[ai][1][m][1][j]); }
                *(f32x4*)(hp) = v0; *(f32x4*)(hp + 4) = v1;
                u32x4 w; w.x = cvt_pk_bf16(v0[0], v0[1]); w.y = cvt_pk_bf16(v0[2], v0[3]); w.z = cvt_pk_bf16(v1[0], v1[1]); w.w = cvt_pk_bf16(v1[2], v1[3]);
                *(u32x4*)(bp) = w;
                rs[ai][m] = (v0[0] * v0[0] + v0[1] * v0[1]) + (v0[2] * v0[2] + v0[3] * v0[3]) + (v1[0] * v1[0] + v1[1] * v1[1]) + (v1[2] * v1[2] + v1[3] * v1[3]);
            }
#pragma unroll
        for (int ai = 0; ai < 2; ++ai)
#pragma unroll
            for (int m = 0; m < 4; ++m) { float s = rs[ai][m]; s += __shfl_xor(s, 16); s += __shfl_xor(s, 32); if (fq == 0) red[(ai * 128 + wr * 64 + m * 16 + fr) * 4 + wc] = s; }
        asm volatile("s_waitcnt lgkmcnt(0)" ::: "memory"); __builtin_amdgcn_s_barrier(); asm volatile("" ::: "memory");
        const int tid = threadIdx.x;
        if (tid < 256) { const f32x4 v = *(const LAS f32x4*)(red + tid * 4); ss[(size_t)(u.pm * 256 + tid) * 16 + u.pn] = (v.x + v.y) + (v.z + v.w); }
    }
};

struct EpiQK {
    static constexpr bool PERM = true;
    bf16_t* qk; const float* ss; int nparts; const float* ropec; const float* ropes; float qscale;
    __device__ __forceinline__ void operator()(const f32x4 (&acc)[2][2][4][2], const Unit& u, int wr, int wc, int fr, int fq) const {
        const int row0 = u.pm * 256 + wr * 64 + fr;
        const int which = wc >> 1, i0 = 32 * (wc & 1) + 8 * fq;
        const int head = 2 * u.pn + which;
        const float sc = (u.pn < 8) ? qscale : 1.0f;
#pragma unroll
        for (int ai = 0; ai < 2; ++ai)
#pragma unroll
            for (int m = 0; m < 4; ++m) {
                const int r = row0 + ai * 128 + m * 16; const float inv = row_inv(ss, r, nparts) * sc; const int pos = row_pos(r);
                const f32x4 c0 = *(const f32x4*)(ropec + pos * 64 + i0), c1 = *(const f32x4*)(ropec + pos * 64 + i0 + 4);
                const f32x4 s0 = *(const f32x4*)(ropes + pos * 64 + i0), s1 = *(const f32x4*)(ropes + pos * 64 + i0 + 4);
                float o1[8], o2[8];
#pragma unroll
                for (int j = 0; j < 4; ++j) {
                    const float xa = acc[ai][0][m][0][j] * inv, xb = acc[ai][1][m][0][j] * inv; o1[j] = xa * c0[j] - xb * s0[j]; o2[j] = xb * c0[j] + xa * s0[j];
                    const float ya = acc[ai][0][m][1][j] * inv, yb = acc[ai][1][m][1][j] * inv; o1[4 + j] = ya * c1[j] - yb * s1[j]; o2[4 + j] = yb * c1[j] + ya * s1[j];
                }
                bf16_t* op = qk + (size_t)r * QKLD + head * 128 + i0;
                u32x4 w; w.x = cvt_pk_bf16(o1[0], o1[1]); w.y = cvt_pk_bf16(o1[2], o1[3]); w.z = cvt_pk_bf16(o1[4], o1[5]); w.w = cvt_pk_bf16(o1[6], o1[7]);
                *(u32x4*)(op) = w;
                w.x = cvt_pk_bf16(o2[0], o2[1]); w.y = cvt_pk_bf16(o2[2], o2[3]); w.z = cvt_pk_bf16(o2[4], o2[5]); w.w = cvt_pk_bf16(o2[6], o2[7]);
                *(u32x4*)(op + 64) = w;
            }
    }
};

struct EpiVt {
    static constexpr bool PERM = true;
    bf16_t* vt; const float* ss; int nparts;
    __device__ __forceinline__ void operator()(const f32x4 (&acc)[2][2][4][2], const Unit& u, int wr, int wc, int fr, int fq) const {
        const int row0 = u.pm * 256 + wr * 64 + fr, col0 = u.pn * 256 + wc * 32 + 8 * fq;
#pragma unroll
        for (int bj = 0; bj < 2; ++bj) {
            float inv[8];
#pragma unroll
            for (int j = 0; j < 8; ++j) inv[j] = row_inv(ss, col0 + bj * 128 + j, nparts);
#pragma unroll
            for (int ai = 0; ai < 2; ++ai)
#pragma unroll
                for (int m = 0; m < 4; ++m) {
                    const int r = row0 + ai * 128 + m * 16;
                    const f32x4 a = acc[ai][bj][m][0], b = acc[ai][bj][m][1];
                    u32x4 w; w.x = cvt_pk_bf16(a[0] * inv[0], a[1] * inv[1]); w.y = cvt_pk_bf16(a[2] * inv[2], a[3] * inv[3]); w.z = cvt_pk_bf16(b[0] * inv[4], b[1] * inv[5]); w.w = cvt_pk_bf16(b[2] * inv[6], b[3] * inv[7]);
                    *(u32x4*)(vt + (size_t)r * MPAD + col0 + bj * 128) = w;
                }
        }
    }
};

struct EpiSloc {
    static constexpr bool PERM = false;
    float* C;
    __device__ __forceinline__ void operator()(const f32x4 (&acc)[2][2][4][2], const Unit& u, int wr, int wc, int fr, int fq) const {
        const int row0 = u.pm * 256 + wr * 64 + fr, col0 = wc * 32 + 4 * fq;
#pragma unroll
        for (int ai = 0; ai < 2; ++ai)
#pragma unroll
            for (int m = 0; m < 4; ++m) { float* rowp = C + (size_t)(row0 + ai * 128 + m * 16) * 256 + col0;
#pragma unroll
                for (int bj = 0; bj < 2; ++bj)
#pragma unroll
                    for (int n = 0; n < 2; ++n) *(f32x4*)(rowp + bj * 128 + n * 16) = acc[ai][bj][m][n]; }
    }
};

struct EpiY {
    static constexpr bool PERM = true;
    bf16_t* z;
    __device__ __forceinline__ void operator()(const f32x4 (&acc)[2][2][4][2], const Unit& u, int wr, int wc, int fr, int fq) const {
        const int g = u.pn, crow0 = (u.pm - 9 * g) * 256 + wr * 64 + fr;
#pragma unroll
        for (int ai = 0; ai < 2; ++ai)
#pragma unroll
            for (int m = 0; m < 4; ++m) {
                const int cr = crow0 + ai * 128 + m * 16;
                if (cr < NCH) {
#pragma unroll
                    for (int bj = 0; bj < 2; ++bj) {
                        const int ncol = 128 * bj + 32 * wc + 8 * fq, t = ncol >> 4, hh = ncol & 15;
                        float o[8];
#pragma unroll
                        for (int n = 0; n < 2; ++n)
#pragma unroll
                            for (int j = 0; j < 4; ++j) { const float y = acc[ai][bj][m][n][j]; const float q = 1.5957691216057308f * (y + 0.044715f * y * y * y); o[n * 4 + j] = y * sigmoidf_(q); }
                        u32x4 w; w.x = cvt_pk_bf16(o[0], o[1]); w.y = cvt_pk_bf16(o[2], o[3]); w.z = cvt_pk_bf16(o[4], o[5]); w.w = cvt_pk_bf16(o[6], o[7]);
                        *(u32x4*)(z + (size_t)chunk_tok_row(cr, t) * D + g * 16 + hh) = w;
                    }
                }
            }
    }
};

struct Ctx { LAS unsigned char* lds; int tid, lane, wave, G, c; };
__device__ __forceinline__ Ctx fresh(const Ctx& F) { Ctx R = F; int t = threadIdx.x; asm volatile("" : "+v"(t)); R.tid = t; R.lane = t & 63; return R; }

__device__ __forceinline__ void transpose_item(const float* W, int K, int N, const float* gain, bf16_t* WT, int out_row0, LAS float* scr, int k0, int n0, int lane) {
#pragma unroll 8
    for (int i = 0; i < 32; ++i) { const int kk = 2 * i + (lane >> 5); float v = W[(size_t)(k0 + kk) * N + n0 + (lane & 31)]; if (gain) v *= gain[k0 + kk]; scr[kk * 33 + (lane & 31)] = v; }
    asm volatile("s_waitcnt lgkmcnt(0)" ::: "memory");
    const int c = lane & 7;
#pragma unroll
    for (int j = 0; j < 4; ++j) { const int n = (lane >> 3) + 8 * j; const LAS float* s = scr + (8 * c) * 33 + n;
        u32x4 o; o.x = cvt_pk_bf16(s[0 * 33], s[1 * 33]); o.y = cvt_pk_bf16(s[2 * 33], s[3 * 33]); o.z = cvt_pk_bf16(s[4 * 33], s[5 * 33]); o.w = cvt_pk_bf16(s[6 * 33], s[7 * 33]);
        *(u32x4*)(WT + (size_t)(out_row0 + n) * K + k0 + 8 * c) = o; }
    asm volatile("s_waitcnt lgkmcnt(0)" ::: "memory");
}
__device__ __forceinline__ void transpose_matrix(const Ctx& F, const float* W, int K, int N, const float* gain, bf16_t* WT, bf16_t* WT2, int kind) {
    LAS float* scr = (LAS float*)(F.lds + F.wave * 16384);
    const int nblk = N / 32, nitems = (K / 64) * nblk;
    const int gw = F.wave * F.G + F.c, NGW = F.G * 8;
    for (int it = gw; it < nitems; it += NGW) {
        const int kb = it / nblk, nb = it - kb * nblk, k0 = 64 * kb, n0 = 32 * nb;
        bf16_t* dst = WT; int row0;
        if (kind == 0) row0 = n0;
        else if (kind == 1) row0 = 256 * (n0 >> 7) + (n0 & 127);
        else if (kind == 2) row0 = 256 * (n0 >> 7) + 128 + (n0 & 127);
        else { if (n0 < 2560) { const int head = n0 >> 7, i0 = n0 & 127; row0 = 256 * (head >> 1) + ((i0 >= 64) ? 128 : 0) + (head & 1) * 64 + (i0 & 63); } else { dst = WT2; row0 = n0 - 2560; } }
        transpose_item(W, K, N, gain, dst, row0, scr, k0, n0, F.lane);
    }
}

__device__ __forceinline__ void phase_init(const Ctx& F, const float* xp, const float* xs, const float* meta, float* h, bf16_t* hb, float* ss, float* ropec, float* ropes,
                                           const float* a_re, const float* a_im, const float* log_dt, const float* b_re, const float* b_im, float* s5t) {
    const int gw = F.c * 8 + F.wave, NGW = F.G * 8;
    for (int r = gw; r < MPAD; r += NGW) {
        const float* src = r < 16384 ? xp + (size_t)r * D : (r < NREAL ? xs + (size_t)(r - 16384) * D : (r < MVALID ? meta + (size_t)((r - NREAL) & 15) * D : nullptr));
        float part[8];
#pragma unroll
        for (int j = 0; j < 8; ++j) {
            f32x4 v = src ? *(const f32x4*)(src + 256 * j + 4 * F.lane) : (f32x4){0.f, 0.f, 0.f, 0.f};
            *(f32x4*)(h + (size_t)r * D + 256 * j + 4 * F.lane) = v;
            u32x2 w; w.x = cvt_pk_bf16(v[0], v[1]); w.y = cvt_pk_bf16(v[2], v[3]);
            *(u32x2*)(hb + (size_t)r * D + 256 * j + 4 * F.lane) = w;
            part[j] = wave_sum((v[0] * v[0] + v[1] * v[1]) + (v[2] * v[2] + v[3] * v[3]));
        }
        if (F.lane < 16) { float v = 0.f;
#pragma unroll
            for (int j = 0; j < 8; ++j) v = (F.lane == j) ? part[j] : v;
            ss[(size_t)r * 16 + F.lane] = v; }
    }
    const int gt = F.c * 512 + F.tid, NGT = F.G * 512;
    for (int e = gt; e < 16400 * 64; e += NGT) {
        const int pos = e >> 6, i = e & 63;
        const double invf = exp2(-(double)i * (13.287712379549449 / 64.0));
        const double ang = (double)pos * invf;
        ropec[e] = (float)cos(ang); ropes[e] = (float)sin(ang);
    }
    for (int e = gt; e < 2 * NG * 2 * 64 * 17; e += NGT) {
        const int q = e % 17, idx = e / 17;
        const int p = idx & 63, dir = (idx >> 6) & 1, g = (idx >> 7) & 127, layer = idx >> 14;
        const size_t pi = ((size_t)(layer * 2 + dir) * NG + g) * 64 + p;
        const double are = a_re[pi], aim = a_im[pi], dt = exp((double)log_dt[(layer * 2 + dir) * NG + g]);
        const double mag = exp(are * dt * q), ang = aim * dt * q;
        s5t[(size_t)e * 2] = (float)(mag * cos(ang)); s5t[(size_t)e * 2 + 1] = (float)(mag * sin(ang));
    }
    for (int e = gt; e < 2 * NG * 2 * 64 * 16; e += NGT) {
        const int hq = e & 15, idx = e >> 4;
        const int p = idx & 63, dir = (idx >> 6) & 1, g = (idx >> 7) & 127, layer = idx >> 14;
        const size_t pi = ((size_t)(layer * 2 + dir) * NG + g) * 64 + p;
        const double are = a_re[pi], aim = a_im[pi], dt = exp((double)log_dt[(layer * 2 + dir) * NG + g]);
        const double mag = exp(are * dt), ang = aim * dt;
        const double nr = mag * cos(ang) - 1.0, ni = mag * sin(ang);
        const double den = are * are + aim * aim;
        const double fr_ = (nr * are + ni * aim) / den, fi_ = (ni * are - nr * aim) / den;
        const double br = b_re[pi * 16 + hq], bim = b_im[pi * 16 + hq];
        s5t[S5T_BB_OFF + (size_t)e * 2] = (float)(fr_ * br - fi_ * bim); s5t[S5T_BB_OFF + (size_t)e * 2 + 1] = (float)(fr_ * bim + fi_ * br);
    }
}

__device__ __forceinline__ void phase_final(const Ctx& F, const float* h, const float* ss, int nparts, const float* fn, float* out) {
    const int gw = F.c * 8 + F.wave, NGW = F.G * 8;
    for (int r = gw; r < NREAL; r += NGW) {
        const float inv = row_inv(ss, r, nparts);
#pragma unroll
        for (int j = 0; j < 8; ++j) {
            const f32x4 v = *(const f32x4*)(h + (size_t)r * D + 256 * j + 4 * F.lane), gq = *(const f32x4*)(fn + 256 * j + 4 * F.lane);
            *(f32x4*)(out + (size_t)r * D + 256 * j + 4 * F.lane) = v * inv * gq;
        }
    }
}

__device__ __forceinline__ void s5_build_group(const Ctx& F, int g, const float* pwt, const float* bbt,
                                               const float* c_re, const float* c_im, const float* dvec, const float* gain, bf16_t* BmatT, bf16_t* WyT, float* A16) {
    LAS float* pw = (LAS float*)F.lds; LAS float* bb = pw + 4352; LAS float* cc = bb + 4096; LAS float* Kt = cc + 4096; LAS float* gn = Kt + 8192; LAS float* dd = gn + 16;
    const int tid = F.tid;
    __syncthreads();
    for (int e = tid; e < 2 * 64 * 17 * 2; e += 512) pw[e] = pwt[(size_t)g * (2 * 64 * 17 * 2) + e];
    for (int e = tid; e < 2 * 64 * 16 * 2; e += 512) bb[e] = bbt[(size_t)g * (2 * 64 * 16 * 2) + e];
    for (int e = tid; e < 2 * 16 * 64; e += 512) {
        const int dir = e >> 10, hh = (e >> 6) & 15, pp = e & 63;
        const size_t ci = ((size_t)((dir * NG + g) * 16 + hh)) * 64 + pp;
        cc[e * 2] = c_re[ci]; cc[e * 2 + 1] = c_im[ci];
    }
    if (tid < 16) { gn[tid] = gain[g * 16 + tid]; dd[tid] = dvec[g * 16 + tid]; }
    __syncthreads();
    {
        const int dir = tid >> 8, hh = (tid >> 4) & 15, hq = tid & 15;
        for (int tau = 0; tau < 16; ++tau) {
            float s = 0.f;
            for (int p = 0; p < 64; ++p) {
                const float cr = cc[((dir * 16 + hh) * 64 + p) * 2], ci = cc[((dir * 16 + hh) * 64 + p) * 2 + 1];
                const float pr = pw[((dir * 64 + p) * 17 + tau) * 2], pi = pw[((dir * 64 + p) * 17 + tau) * 2 + 1];
                const float zr = cr * pr - ci * pi, zi = cr * pi + ci * pr;
                const float br = bb[((dir * 64 + p) * 16 + hq) * 2], bi = bb[((dir * 64 + p) * 16 + hq) * 2 + 1];
                s += zr * br - zi * bi;
            }
            Kt[(dir * 16 + tau) * 256 + hh * 16 + hq] = s;
        }
    }
    __syncthreads();
    bf16_t* Bg = BmatT + (size_t)g * 256 * 256; bf16_t* Wg = WyT + (size_t)g * 256 * 512;
    for (int q = tid; q < 256 * 32; q += 512) {
        const int n = q >> 5, k0 = (q & 31) * 8, t = n >> 4, hh = n & 15, j = k0 >> 4, h0 = k0 & 15;
        float o[8];
#pragma unroll
        for (int e = 0; e < 8; ++e) {
            const int hq = h0 + e; float v = 0.f;
            if (j <= t) v += Kt[(0 * 16 + (t - j)) * 256 + hh * 16 + hq];
            if (j >= t) v += Kt[(1 * 16 + (j - t)) * 256 + hh * 16 + hq];
            if (j == t && hq == hh) v += dd[hh];
            o[e] = v * gn[hq];
        }
        u32x4 w; w.x = cvt_pk_bf16(o[0], o[1]); w.y = cvt_pk_bf16(o[2], o[3]); w.z = cvt_pk_bf16(o[4], o[5]); w.w = cvt_pk_bf16(o[6], o[7]);
        *(u32x4*)(Wg + (size_t)n * 512 + k0) = w;
    }
    for (int q = tid; q < 256 * 32; q += 512) {
        const int n = q >> 5, r0 = (q & 31) * 8, t = n >> 4, hh = n & 15, dir = r0 >> 7, part = (r0 >> 6) & 1, p0 = r0 & 63;
        const int ex = dir == 0 ? t + 1 : 16 - t;
        float o[8];
#pragma unroll
        for (int e = 0; e < 8; ++e) {
            const int p = p0 + e;
            const float cr = cc[((dir * 16 + hh) * 64 + p) * 2], ci = cc[((dir * 16 + hh) * 64 + p) * 2 + 1];
            const float pr = pw[((dir * 64 + p) * 17 + ex) * 2], pi = pw[((dir * 64 + p) * 17 + ex) * 2 + 1];
            o[e] = part == 0 ? (cr * pr - ci * pi) : -(cr * pi + ci * pr);
        }
        u32x4 w; w.x = cvt_pk_bf16(o[0], o[1]); w.y = cvt_pk_bf16(o[2], o[3]); w.z = cvt_pk_bf16(o[4], o[5]); w.w = cvt_pk_bf16(o[6], o[7]);
        *(u32x4*)(Wg + (size_t)n * 512 + 256 + r0) = w;
    }
    for (int q = tid; q < 256 * 32; q += 512) {
        const int col = q >> 5, k0 = (q & 31) * 8, dir = col >> 7, part = (col >> 6) & 1, p = col & 63, j = k0 >> 4, h0 = k0 & 15;
        const int ex = dir == 0 ? 15 - j : j;
        const float pr = pw[((dir * 64 + p) * 17 + ex) * 2], pi = pw[((dir * 64 + p) * 17 + ex) * 2 + 1];
        float o[8];
#pragma unroll
        for (int e = 0; e < 8; ++e) {
            const int hq = h0 + e;
            const float br = bb[((dir * 64 + p) * 16 + hq) * 2], bi = bb[((dir * 64 + p) * 16 + hq) * 2 + 1];
            o[e] = (part == 0 ? (pr * br - pi * bi) : (pr * bi + pi * br)) * gn[hq];
        }
        u32x4 w; w.x = cvt_pk_bf16(o[0], o[1]); w.y = cvt_pk_bf16(o[2], o[3]); w.z = cvt_pk_bf16(o[4], o[5]); w.w = cvt_pk_bf16(o[6], o[7]);
        *(u32x4*)(Bg + (size_t)col * 256 + k0) = w;
    }
    if (tid < 128) { const int dir = tid >> 6, p = tid & 63; A16[((g * 2 + dir) * 64 + p) * 2] = pw[((dir * 64 + p) * 17 + 16) * 2]; A16[((g * 2 + dir) * 64 + p) * 2 + 1] = pw[((dir * 64 + p) * 17 + 16) * 2 + 1]; }
    __syncthreads();
}

__device__ __forceinline__ void phase_s5a(const Ctx& F, const float* h, const float* ss, int nparts, bf16_t* XS) {
    LAS bf16_t* buf = (LAS bf16_t*)F.lds;
    for (int cr = F.c; cr < NCH; cr += F.G) {
        __syncthreads();
#pragma unroll
        for (int q = 0; q < 2; ++q) {
            const int t = F.wave * 2 + q, r = chunk_tok_row(cr, t); const float inv = row_inv(ss, r, nparts);
#pragma unroll
            for (int j = 0; j < 8; ++j) {
                const f32x4 v = *(const f32x4*)(h + (size_t)r * D + 256 * j + 4 * F.lane) * inv;
                u32x2 w; w.x = cvt_pk_bf16(v[0], v[1]); w.y = cvt_pk_bf16(v[2], v[3]);
                *(LAS u32x2*)(buf + t * 2048 + 256 * j + 4 * F.lane) = w;
            }
        }
        __syncthreads();
#pragma unroll
        for (int i = 0; i < 8; ++i) {
            const int q = F.tid + 512 * i, g = q >> 5, t = (q >> 1) & 15, half = q & 1;
            const u32x4 w = *(const LAS u32x4*)(buf + t * 2048 + g * 16 + half * 8);
            *(u32x4*)(XS + ((size_t)g * NCHP + cr) * 512 + t * 16 + half * 8) = w;
        }
    }
    __syncthreads();
}

__device__ __forceinline__ void phase_scan(const Ctx& F, const float* Sloc, bf16_t* XS, const float* A16) {
    const int wtask = F.wave * F.G + F.c;
    if (wtask >= 768) return;
    const int so = wtask >> 8, g = (wtask >> 1) & 127, dir = wtask & 1, p = F.lane;
    const int s = so == 0 ? 2 : so - 1;
    const int crb = s == 2 ? 1026 : (s == 1 ? 513 : 0), n = s == 2 ? 1025 : 513;
    const float ar = A16[((g * 2 + dir) * 64 + p) * 2], ai = A16[((g * 2 + dir) * 64 + p) * 2 + 1];
    const float* src = Sloc + ((size_t)g * NCHP + crb) * 256 + dir * 128 + p;
    bf16_t* dst = XS + ((size_t)g * NCHP + crb) * 512 + 256 + dir * 128 + p;
    float sr = 0.f, si = 0.f;
    for (int c0 = 0; c0 < n; c0 += 8) {
        float lr[8], li[8];
#pragma unroll
        for (int k = 0; k < 8; ++k) { int c = c0 + k; c = c < n ? c : n - 1; const int ci = dir ? n - 1 - c : c; lr[k] = src[(size_t)ci * 256]; li[k] = src[(size_t)ci * 256 + 64]; }
#pragma unroll
        for (int k = 0; k < 8; ++k) {
            const int c = c0 + k;
            if (c < n) {
                const int ci = dir ? n - 1 - c : c;
                const unsigned pk = cvt_pk_bf16(sr, si);
                dst[(size_t)ci * 512] = (bf16_t)(pk & 0xffffu); dst[(size_t)ci * 512 + 64] = (bf16_t)(pk >> 16);
                const float nr = ar * sr - ai * si + lr[k], ni = ar * si + ai * sr + li[k];
                sr = nr; si = ni;
            }
        }
    }
}

__device__ __forceinline__ void phase_attn(const Ctx& F, const bf16_t* QK, const bf16_t* Vt, bf16_t* O, const float* sink) {
    const int lane = F.lane, r = lane & 31, hh = lane >> 5, wave = F.wave;
    for (int unit = F.c; unit < 2048 + 12; unit += F.G) {
        int s, kh, qrow, head, pq, kt0, kt1; bool active = true;
        if (unit < 2048) {
            const int qb = unit >> 2; kh = unit & 3; head = kh * 4 + (wave >> 1);
            const int qw = qb * 64 + (wave & 1) * 32;
            s = qw >= 16384 ? 2 : (qw >= 8192 ? 1 : 0);
            const int rb = s == 2 ? 16384 : s * 8192, S = s == 2 ? 16384 : 8192, qrel = qw - rb;
            qrow = qw + r; pq = qrel + r + 16;
            int lo = qrel - 128; lo = lo < 0 ? 0 : lo; int hi = qrel + 160; hi = hi > S ? S : hi;
            kt0 = lo >> 5; kt1 = hi >> 5;
        } else {
            const int mu = unit - 2048; s = mu >> 2; kh = mu & 3; active = wave < 2;
            head = kh * 4 + wave * 2 + (r >> 4); qrow = NREAL + 16 * s + (r & 15); pq = r & 15; kt0 = 0; kt1 = 4;
        }
        if (!active) continue;
        const int rb = s == 2 ? 16384 : s * 8192;
        bf16x8 qf[8];
#pragma unroll
        for (int ks = 0; ks < 8; ++ks) qf[ks] = *(const bf16x8*)(QK + (size_t)qrow * QKLD + head * 128 + 16 * ks + 8 * hh);
        f32x16 o[4];
#pragma unroll
        for (int db = 0; db < 4; ++db)
#pragma unroll
            for (int e = 0; e < 16; ++e) o[db][e] = 0.f;
        float mrun = sink[head] * LOG2E, lrun = 1.0f;
        for (int kt = kt0 - 1; kt < kt1; ++kt) {
            const bool ismeta = kt < kt0;
            const int krow0 = ismeta ? NREAL + 16 * s : rb + kt * 32;
            const int krow = ismeta ? krow0 + (r & 15) : krow0 + r;
            f32x16 sc;
#pragma unroll
            for (int e = 0; e < 16; ++e) sc[e] = 0.f;
#pragma unroll
            for (int ks = 0; ks < 8; ++ks) {
                const bf16x8 kf = *(const bf16x8*)(QK + (size_t)krow * QKLD + 2048 + kh * 128 + 16 * ks + 8 * hh);
                sc = __builtin_amdgcn_mfma_f32_32x32x16_bf16(kf, qf[ks], sc, 0, 0, 0);
            }
            float mx = -INFINITY;
#pragma unroll
            for (int e = 0; e < 16; ++e) {
                const int kl = (e & 3) + 8 * (e >> 2) + 4 * hh;
                bool ok;
                if (ismeta) ok = kl < 16; else { const int dlt = pq - (kt * 32 + kl + 16); ok = (dlt <= 128) && (dlt >= -128); }
                sc[e] = ok ? sc[e] : -INFINITY; mx = fmaxf(mx, sc[e]);
            }
            mx = fmaxf(mx, __shfl_xor(mx, 32));
            const float mnew = fmaxf(mrun, mx), alpha = fast_exp2(mrun - mnew);
            float psum = 0.f;
#pragma unroll
            for (int e = 0; e < 16; ++e) { sc[e] = fast_exp2(sc[e] - mnew); psum += sc[e]; }
            psum += __shfl_xor(psum, 32);
            lrun = lrun * alpha + psum; mrun = mnew;
#pragma unroll
            for (int db = 0; db < 4; ++db)
#pragma unroll
                for (int e = 0; e < 16; ++e) o[db][e] *= alpha;
            bf16x8 pf[2];
#pragma unroll
            for (int sx = 0; sx < 2; ++sx) {
                u32x4 w; w.x = cvt_pk_bf16(sc[8 * sx + 0], sc[8 * sx + 1]); w.y = cvt_pk_bf16(sc[8 * sx + 2], sc[8 * sx + 3]); w.z = cvt_pk_bf16(sc[8 * sx + 4], sc[8 * sx + 5]); w.w = cvt_pk_bf16(sc[8 * sx + 6], sc[8 * sx + 7]);
                pf[sx] = __builtin_bit_cast(bf16x8, w);
            }
#pragma unroll
            for (int sx = 0; sx < 2; ++sx) {
                if (ismeta && sx == 1) continue;
#pragma unroll
                for (int db = 0; db < 4; ++db) {
                    const bf16_t* vp = Vt + (size_t)(kh * 128 + 32 * db + r) * MPAD + krow0 + 16 * sx + 4 * hh;
                    const u32x2 lo2 = *(const u32x2*)(vp), hi2 = *(const u32x2*)(vp + 8);
                    u32x4 w; w.x = lo2.x; w.y = lo2.y; w.z = hi2.x; w.w = hi2.y;
                    o[db] = __builtin_amdgcn_mfma_f32_32x32x16_bf16(__builtin_bit_cast(bf16x8, w), pf[sx], o[db], 0, 0, 0);
                }
            }
        }
        const float il = 1.0f / lrun;
#pragma unroll
        for (int db = 0; db < 4; ++db)
#pragma unroll
            for (int eq = 0; eq < 4; ++eq) {
                u32x2 w; w.x = cvt_pk_bf16(o[db][4 * eq + 0] * il, o[db][4 * eq + 1] * il); w.y = cvt_pk_bf16(o[db][4 * eq + 2] * il, o[db][4 * eq + 3] * il);
                *(u32x2*)(O + (size_t)qrow * D + head * 128 + 32 * db + 8 * eq + 4 * hh) = w;
            }
    }
}

__device__ __forceinline__ void zero_pad_rows(const Ctx& F, bf16_t* buf) {
    const int gt = F.c * 512 + F.tid, NGT = F.G * 512;
    unsigned z = 0u; asm volatile("" : "+v"(z));
    for (int e = gt; e < (MPAD - MVALID) * D / 8; e += NGT) *(u32x4*)(buf + (size_t)MVALID * D + (size_t)e * 8) = (u32x4){z, z, z, z};
}

struct Args { const float* in[20]; float* out; unsigned char* ws; int ph_lo, ph_hi, li, pad; };
constexpr int PH_FINAL = 41, PH_END = 42;

typedef const __attribute__((address_space(4))) Args* KArgs;
__device__ __forceinline__ KArgs kargs() { KArgs p = (KArgs)__builtin_amdgcn_kernarg_segment_ptr(); asm volatile("" : "+s"(p)); return p; }

__global__ void __launch_bounds__(512, 2) fwd_kernel(Args args) {
    extern __shared__ __attribute__((aligned(16))) unsigned char lds_raw[];
    Ctx F; F.lds = (LAS unsigned char*)lds_raw; F.tid = threadIdx.x; F.lane = F.tid & 63; F.wave = __builtin_amdgcn_readfirstlane(F.tid >> 6); F.G = gridDim.x; F.c = blockIdx.x;
    volatile LAS unsigned* MISC = (volatile LAS unsigned*)(F.lds + MISC_OFF);
    if (F.tid < 64) MISC[F.tid] = 0u;
    __syncthreads();
    XcdBarrier bar = xcd_barrier_post((unsigned*)(args.ws + WS_CTL) + 4096 + args.li * XCD_BAR_WORDS, MISC + 8);
    const int lo = args.ph_lo, hi = args.ph_hi;
#ifndef PHMASK
#define PHMASK 0xFFFF
#endif
#define IN(k) (lo <= (k) && (k) < hi)
#define EN(b) ((PHMASK >> (b)) & 1)
#define SEAM(k) do { if ((k) + 1 < hi) xcd_barrier(bar); } while (0)
#define WSP(T, off) ((T*)(ws + (off)))

    if (EN(0) && IN(0)) { KArgs ka = kargs(); unsigned char* ws = ka->ws;
        phase_init(fresh(F), ka->in[0], ka->in[1], ka->in[2], WSP(float, WS_H), WSP(bf16_t, WS_HB), WSP(float, WS_SS), WSP(float, WS_ROPE), WSP(float, WS_ROPE + ROPE_HALF),
                   ka->in[8], ka->in[9], ka->in[10], ka->in[11], ka->in[12], WSP(float, WS_S5T)); SEAM(0); }

    int nparts = 8;
    for (int sb = 0; sb < 12; ++sb) {
        const int layer = sb / 3, kind = sb - 3 * layer, pbase = 1 + 10 * layer, jm = layer >> 1;
        const bool is_s5 = (layer & 1) == 0;
        if (kind == 0) {
            if (EN(1) && IN(pbase)) {
                if (is_s5) {
                    { KArgs ka = kargs(); unsigned char* ws = ka->ws;
                      for (int g = F.c; g < NG; g += F.G)
                        s5_build_group(fresh(F), g, WSP(float, WS_S5T) + (size_t)jm * S5T_PW_L, WSP(float, WS_S5T) + S5T_BB_OFF + (size_t)jm * S5T_BB_L,
                                       ka->in[13] + (size_t)jm * 2 * NG * 16 * 64, ka->in[14] + (size_t)jm * 2 * NG * 16 * 64,
                                       ka->in[15] + (size_t)jm * D, ka->in[3] + (size_t)(layer * 3 + 1) * D, WSP(bf16_t, WS_WMIX + MIX_BMAT), WSP(bf16_t, WS_WMIX + MIX_WY), WSP(float, WS_A16)); }
                    __syncthreads();
                    { KArgs ka = kargs(); unsigned char* ws = ka->ws;
                      transpose_matrix(fresh(F), ka->in[16] + (size_t)(jm * 2 + 0) * D * D, D, D, nullptr, WSP(bf16_t, WS_WMIX + MIX_WGLU), nullptr, 1);
                      transpose_matrix(fresh(F), ka->in[16] + (size_t)(jm * 2 + 1) * D * D, D, D, nullptr, WSP(bf16_t, WS_WMIX + MIX_WGLU), nullptr, 2); }
                } else {
                    KArgs ka = kargs(); unsigned char* ws = ka->ws;
                    transpose_matrix(fresh(F), ka->in[17] + (size_t)jm * D * 3072, D, 3072, ka->in[3] + (size_t)(layer * 3 + 1) * D, WSP(bf16_t, WS_WMIX + MIX_WQK), WSP(bf16_t, WS_WMIX + MIX_WVT), 3);
                    transpose_matrix(fresh(F), ka->in[18] + (size_t)jm * D * D, D, D, nullptr, WSP(bf16_t, WS_WMIX + MIX_WO), nullptr, 0);
                }
                for (int hf = 0; hf < 2; ++hf) {
                    KArgs ka = kargs(); unsigned char* ws = ka->ws;
                    const size_t wi = (size_t)(layer * 2 + hf); const float* gn = ka->in[3] + (size_t)(layer * 3 + 2 * hf) * D;
                    transpose_matrix(fresh(F), ka->in[5] + wi * D * DFF, D, DFF, gn, WSP(bf16_t, hf ? WS_WGU_B : WS_WGU_A), nullptr, 1);
                    transpose_matrix(fresh(F), ka->in[6] + wi * D * DFF, D, DFF, gn, WSP(bf16_t, hf ? WS_WGU_B : WS_WGU_A), nullptr, 2);
                    transpose_matrix(fresh(F), ka->in[7] + wi * DFF * D, DFF, D, nullptr, WSP(bf16_t, hf ? WS_WD_B : WS_WD_A), nullptr, 0);
                }
                __syncthreads();
                SEAM(pbase);
            }
        }
        if (kind != 1) {
            const int p1 = pbase + (kind == 0 ? 1 : 8), p2 = p1 + 1;
            if (EN(2) && IN(p1)) {
                KArgs ka = kargs(); unsigned char* ws = ka->ws;
                pg8::Gemm g{WSP(bf16_t, WS_HB), WSP(bf16_t, kind == 0 ? WS_WGU_A : WS_WGU_B), D, D, D}; pg8::StaticOrder S; S.init(MPAD, 2 * DFF, F.G, F.c);
                EpiSwiGLU E{WSP(bf16_t, WS_ACT), WSP(float, WS_SS), nparts};
                pg8::gemm_phase<EpiSwiGLU, pg8::StaticOrder>(F.lds, g, S, E);
                SEAM(p1);
            }
            if (EN(3) && IN(p2)) {
                KArgs ka = kargs(); unsigned char* ws = ka->ws;
                pg8::Gemm g{WSP(bf16_t, WS_ACT), WSP(bf16_t, kind == 0 ? WS_WD_A : WS_WD_B), DFF, DFF, DFF}; pg8::StaticOrder S; S.init(MPAD, D, F.G, F.c);
                EpiResid E{WSP(float, WS_H), WSP(bf16_t, WS_HB), WSP(float, WS_SS), 0.5f, (LAS float*)(F.lds + RED_OFF)};
                pg8::gemm_phase<EpiResid, pg8::StaticOrder>(F.lds, g, S, E);
                SEAM(p2);
            }
            nparts = 8;
        } else if (is_s5) {
            if (EN(4) && IN(pbase + 3)) { KArgs ka = kargs(); unsigned char* ws = ka->ws; phase_s5a(fresh(F), WSP(float, WS_H), WSP(float, WS_SS), nparts, WSP(bf16_t, WS_ACT)); SEAM(pbase + 3); }
            if (EN(5) && IN(pbase + 4)) {
                KArgs ka = kargs(); unsigned char* ws = ka->ws;
                pg8::Gemm g{WSP(bf16_t, WS_ACT), WSP(bf16_t, WS_WMIX + MIX_BMAT), 512, 256, 256}; pg8::BlockDiagOrder S; S.init(F.G, F.c);
                EpiSloc E{WSP(float, WS_R2)};
                pg8::gemm_phase<EpiSloc, pg8::BlockDiagOrder>(F.lds, g, S, E);
                SEAM(pbase + 4);
            }
            if (EN(6) && IN(pbase + 5)) { KArgs ka = kargs(); unsigned char* ws = ka->ws; phase_scan(fresh(F), WSP(float, WS_R2), WSP(bf16_t, WS_ACT), WSP(float, WS_A16)); SEAM(pbase + 5); }
            if (EN(7) && IN(pbase + 6)) {
                KArgs ka = kargs(); unsigned char* ws = ka->ws;
                pg8::Gemm g{WSP(bf16_t, WS_ACT), WSP(bf16_t, WS_WMIX + MIX_WY), 512, 512, 512}; pg8::BlockDiagOrder S; S.init(F.G, F.c);
                EpiY E{WSP(bf16_t, WS_R2)};
                pg8::gemm_phase<EpiY, pg8::BlockDiagOrder>(F.lds, g, S, E);
                zero_pad_rows(fresh(F), WSP(bf16_t, WS_R2));
                SEAM(pbase + 6);
            }
            if (EN(8) && IN(pbase + 7)) {
                KArgs ka = kargs(); unsigned char* ws = ka->ws;
                pg8::Gemm g{WSP(bf16_t, WS_R2), WSP(bf16_t, WS_WMIX + MIX_WGLU), D, D, D}; pg8::StaticOrder S; S.init(MPAD, 2 * D, F.G, F.c);
                EpiGLU E{WSP(float, WS_H), WSP(bf16_t, WS_HB), WSP(float, WS_SS), (LAS float*)(F.lds + RED_OFF)};
                pg8::gemm_phase<EpiGLU, pg8::StaticOrder>(F.lds, g, S, E);
                SEAM(pbase + 7);
            }
            nparts = 16;
        } else {
            if (EN(9) && IN(pbase + 3)) {
                { KArgs ka = kargs(); unsigned char* ws = ka->ws;
                  pg8::Gemm g{WSP(bf16_t, WS_HB), WSP(bf16_t, WS_WMIX + MIX_WQK), D, D, D}; pg8::StaticOrder S; S.init(MPAD, QKLD, F.G, F.c);
                  EpiQK E{WSP(bf16_t, WS_ACT), WSP(float, WS_SS), nparts, WSP(float, WS_ROPE), WSP(float, WS_ROPE + ROPE_HALF), 0.08838834764831845f * LOG2E};
                  pg8::gemm_phase<EpiQK, pg8::StaticOrder>(F.lds, g, S, E); }
                { KArgs ka = kargs(); unsigned char* ws = ka->ws;
                  pg8::Gemm g{WSP(bf16_t, WS_WMIX + MIX_WVT), WSP(bf16_t, WS_HB), D, D, D}; pg8::StaticOrder S; S.init(512, MPAD, F.G, F.c);
                  EpiVt E{WSP(bf16_t, WS_VT), WSP(float, WS_SS), nparts};
                  pg8::gemm_phase<EpiVt, pg8::StaticOrder>(F.lds, g, S, E); }
                SEAM(pbase + 3);
            }
            if (EN(10) && IN(pbase + 4)) { KArgs ka = kargs(); unsigned char* ws = ka->ws;
                phase_attn(fresh(F), WSP(bf16_t, WS_ACT), WSP(bf16_t, WS_VT), WSP(bf16_t, WS_R2), ka->in[19] + jm * 16); zero_pad_rows(fresh(F), WSP(bf16_t, WS_R2)); SEAM(pbase + 4); }
            if (EN(11) && IN(pbase + 5)) {
                KArgs ka = kargs(); unsigned char* ws = ka->ws;
                pg8::Gemm g{WSP(bf16_t, WS_R2), WSP(bf16_t, WS_WMIX + MIX_WO), D, D, D}; pg8::StaticOrder S; S.init(MPAD, D, F.G, F.c);
                EpiResid E{WSP(float, WS_H), WSP(bf16_t, WS_HB), WSP(float, WS_SS), 1.0f, (LAS float*)(F.lds + RED_OFF)};
                pg8::gemm_phase<EpiResid, pg8::StaticOrder>(F.lds, g, S, E);
                SEAM(pbase + 5);
            }
            nparts = 8;
        }
    }
    if (EN(12) && IN(PH_FINAL)) { KArgs ka = kargs(); unsigned char* ws = ka->ws; phase_final(fresh(F), WSP(float, WS_H), WSP(float, WS_SS), nparts, ka->in[4], ka->out); }
#undef IN
#undef SEAM
#undef EN
#undef WSP
}

#ifndef N_LAUNCH_MODE
#define N_LAUNCH_MODE 0
#endif
extern "C" void kernel_launch(void* const* d_in, const int* in_sizes, int n_in, void* d_out, int out_size, void* d_ws, size_t ws_size, hipStream_t stream) {
    static int grid = 0;
    if (grid == 0) {
        if (n_in != 20 || ws_size < WS_END) { fprintf(stderr, "kernel_launch: need 20 inputs and %zu bytes of workspace (got %d, %zu)\n", (size_t)WS_END, n_in, ws_size); grid = -1; return; }
        int dev = 0, cus = 0, per_cu = 0;
        if (hipGetDevice(&dev) != hipSuccess || hipDeviceGetAttribute(&cus, hipDeviceAttributeMultiprocessorCount, dev) != hipSuccess) { grid = -1; return; }
        if (hipFuncSetAttribute((const void*)fwd_kernel, hipFuncAttributeMaxDynamicSharedMemorySize, LDS_BYTES) != hipSuccess) { fprintf(stderr, "kernel_launch: hipFuncSetAttribute failed\n"); grid = -1; return; }
        if (hipOccupancyMaxActiveBlocksPerMultiprocessor(&per_cu, (const void*)fwd_kernel, 512, LDS_BYTES) != hipSuccess || per_cu < 1) { fprintf(stderr, "kernel_launch: occupancy query says %d blocks per CU\n", per_cu); grid = -1; (void)hipGetLastError(); return; }
        grid = cus;
    }
    if (grid < 0) return;
    hipMemsetAsync((char*)d_ws + WS_CTL, 0, CTL_BYTES, stream);
    Args a{};
    for (int i = 0; i < 20; ++i) a.in[i] = (const float*)d_in[i];
    a.out = (float*)d_out; a.ws = (unsigned char*)d_ws; a.pad = 0;
#if N_LAUNCH_MODE == 0
    a.ph_lo = 0; a.ph_hi = PH_END; a.li = 0;
    hipLaunchKernelGGL(fwd_kernel, dim3(grid), dim3(512), LDS_BYTES, stream, a);
#else
    for (int p = 0; p < PH_END; ++p) { a.ph_lo = p; a.ph_hi = p + 1; a.li = p; hipLaunchKernelGGL(fwd_kernel, dim3(grid), dim3(512), LDS_BYTES, stream, a); }
#endif
}
```

```cpp
#include <hip/hip_runtime.h>
#include <cstdio>
#include <cstdint>

#ifndef TIMING
#define TIMING 0
#endif
#define PROBE_DOUBLE 0x000
#define NREP(k) (((PROBE_DOUBLE >> (k)) & 1) ? 2 : 1)
#define PROBE_EMPTY_EPI 0
#define TAIL_DIRECT 1
#define PREP_MODE 2
#define TIMING_A 0x004
#define TIMING_B 0x008
#define TIMING_BSCALE 10.0f

#define LAS __attribute__((address_space(3)))
typedef unsigned short bf16_t;
typedef short bf16x8 __attribute__((ext_vector_type(8)));
typedef float f32x4 __attribute__((ext_vector_type(4)));
typedef float f32x2 __attribute__((ext_vector_type(2)));
typedef float f32x16 __attribute__((ext_vector_type(16)));
typedef unsigned u32x4 __attribute__((ext_vector_type(4)));
typedef unsigned u32x2 __attribute__((ext_vector_type(2)));

constexpr int D = 2048, DFF = 5632, NREAL = 32768, MVALID = 32816, MPAD = 33024;
constexpr int NG = 128, NCH = 2051, NCHP = 2304;
constexpr int QKLD = 2560;
constexpr float RMS_EPS = 1e-6f;
constexpr float LOG2E = 1.4426950408889634f;

constexpr size_t MiB = 1u << 20;
constexpr size_t WS_CTL = 0, CTL_BYTES = 1 * MiB;
constexpr size_t WS_ROPE = 1 * MiB;
constexpr size_t ROPE_HALF = (size_t)16400 * 64 * 4;
constexpr size_t WS_SS = 10 * MiB;
constexpr size_t WS_A16 = 13 * MiB;
constexpr size_t WS_SST = WS_A16 + 512 * 1024;
constexpr size_t WS_W1 = 14 * MiB;
constexpr size_t WS_HB = 272 * MiB;
constexpr size_t WS_ACT = 401 * MiB;
constexpr size_t WS_VT = WS_ACT + 162 * MiB;
constexpr size_t WS_R2 = 756 * MiB;
constexpr size_t WS_W = 1044 * MiB;
constexpr size_t OW_WGU_A = 0, OW_WD_A = 44 * MiB, OW_WGU_B = 66 * MiB, OW_WD_B = 110 * MiB, OW_WMIX = 132 * MiB;
constexpr size_t WS_S5T = WS_W + 196 * MiB;
constexpr size_t S5T_PW_L = (size_t)NG * 2 * 64 * 17 * 2, S5T_BB_L = (size_t)NG * 2 * 64 * 16 * 2, S5T_BB_OFF = 2 * S5T_PW_L;
constexpr size_t WS_PART = WS_S5T + 10 * MiB;
constexpr size_t WS_END = WS_PART + 12 * MiB;
constexpr int CW_TICK = 180000;
constexpr size_t MIX_WGLU = 0, MIX_BMAT = 16 * MiB, MIX_WY = 32 * MiB;
constexpr size_t MIX_WQK = 0, MIX_WVT = 10 * MiB, MIX_WO = 12 * MiB;

constexpr int RING_BYTES = 131072, RED_OFF = 131072, MISC_OFF = 131072 + 4096, LDS_BYTES = 147456;
constexpr int INVC_OFF = MISC_OFF + 1024;

__device__ __forceinline__ unsigned cvt_pk_bf16(float lo, float hi) { unsigned r; asm volatile("v_cvt_pk_bf16_f32 %0, %1, %2" : "=v"(r) : "v"(lo), "v"(hi)); return r; }
__device__ __forceinline__ void unpack8(const u32x4 w, f32x4& a, f32x4& b) {
    a[0] = __builtin_bit_cast(float, w.x << 16); a[1] = __builtin_bit_cast(float, w.x & 0xffff0000u); a[2] = __builtin_bit_cast(float, w.y << 16); a[3] = __builtin_bit_cast(float, w.y & 0xffff0000u);
    b[0] = __builtin_bit_cast(float, w.z << 16); b[1] = __builtin_bit_cast(float, w.z & 0xffff0000u); b[2] = __builtin_bit_cast(float, w.w << 16); b[3] = __builtin_bit_cast(float, w.w & 0xffff0000u);
}
__device__ __forceinline__ float fast_exp2(float x) { return __builtin_amdgcn_exp2f(x); }
__device__ __forceinline__ float fast_rcp(float x) { return __builtin_amdgcn_rcpf(x); }
__device__ __forceinline__ float sigmoidf_(float x) { return fast_rcp(1.0f + fast_exp2(-x * LOG2E)); }
__device__ __forceinline__ float wave_sum(float v) {
#pragma unroll
    for (int o = 1; o < 64; o <<= 1) v += __shfl_xor(v, o);
    return v;
}
__device__ __forceinline__ float row_inv(const float* ss, int row, int nparts) {
    const f32x4* p = (const f32x4*)(ss + (size_t)row * 16);
    f32x4 a = p[0], b = p[1];
    float s = (a.x + a.y) + (a.z + a.w) + (b.x + b.y) + (b.z + b.w);
    if (nparts > 8) { f32x4 c = p[2], d = p[3]; s += (c.x + c.y) + (c.z + c.w) + (d.x + d.y) + (d.z + d.w); }
    return rsqrtf(s * (1.0f / D) + RMS_EPS);
}
__device__ __forceinline__ void row_inv8(const float* ss, int nparts, int row0, int fq, float (&inv)[2][4]) {
    const int lane = __builtin_amdgcn_mbcnt_hi(~0u, __builtin_amdgcn_mbcnt_lo(~0u, 0u));
    const int ai_ = fq >> 1, m0 = (fq & 1) * 2;
    const f32x4* pa = (const f32x4*)(ss + (size_t)(row0 + ai_ * 128 + m0 * 16) * 16); const f32x4* pb = pa + 64;
    const f32x4 a0 = pa[0], a1 = pa[1], a2 = pa[2], a3 = pa[3], b0 = pb[0], b1 = pb[1], b2 = pb[2], b3 = pb[3];
    float sa = (a0.x + a0.y) + (a0.z + a0.w) + (a1.x + a1.y) + (a1.z + a1.w), sb = (b0.x + b0.y) + (b0.z + b0.w) + (b1.x + b1.y) + (b1.z + b1.w);
    const float xa = (a2.x + a2.y) + (a2.z + a2.w) + (a3.x + a3.y) + (a3.z + a3.w), xb = (b2.x + b2.y) + (b2.z + b2.w) + (b3.x + b3.y) + (b3.z + b3.w);
    sa += nparts > 8 ? xa : 0.f; sb += nparts > 8 ? xb : 0.f;
    const float a = rsqrtf(sa * (1.0f / D) + RMS_EPS), b = rsqrtf(sb * (1.0f / D) + RMS_EPS);
#pragma unroll
    for (int ai = 0; ai < 2; ++ai)
#pragma unroll
        for (int m = 0; m < 4; ++m) { const int src = (lane & 15) + 16 * (2 * ai + (m >> 1)); const float va = __shfl(a, src), vb = __shfl(b, src); inv[ai][m] = (m & 1) ? vb : va; }
}
__device__ __forceinline__ int chunk_tok_row(int cr, int t) {
    const int s = cr >= 1026 ? 2 : (cr >= 513 ? 1 : 0);
    const int c = cr - (s == 2 ? 1026 : (s == 1 ? 513 : 0));
    const int rb = s == 2 ? 16384 : (s == 1 ? 8192 : 0);
    return c == 0 ? NREAL + 16 * s + t : rb + (c - 1) * 16 + t;
}
__device__ __forceinline__ size_t blk(int r, int k, int KT) { return ((size_t)((r >> 8) * KT + (k >> 6)) << 14) + (size_t)(((k >> 5) & 1) * 8192 + (r & 255) * 32 + (k & 31)); }
__device__ __forceinline__ int row_pos(int r) {
    if (r >= NREAL) return (r - NREAL) & 15;
    const int rb = r >= 16384 ? 16384 : (r >= 8192 ? 8192 : 0);
    return 16 + r - rb;
}

#define XB_TMO      128
#define XB_XCNT(j)  (256  + 64 * (j))
#define XB_XSUB(j)  (1280 + 64 * (j))
#define XB_XGEN(j)  (2304 + 64 * (j))
#define XB_TOP      3328
#define XB_TOPGEN   3392
#define XCD_BAR_WORDS 3456
#define XB_SPIN_CAP (1u << 20)

__device__ __forceinline__ unsigned xb_ld(unsigned* p)              { return __hip_atomic_load(p, __ATOMIC_RELAXED, __HIP_MEMORY_SCOPE_AGENT); }
__device__ __forceinline__ unsigned xb_add(unsigned* p, unsigned v) { return __hip_atomic_fetch_add(p, v, __ATOMIC_RELAXED, __HIP_MEMORY_SCOPE_AGENT); }
__device__ __forceinline__ unsigned xb_xcc_id() { return (unsigned)__builtin_amdgcn_s_getreg((3 << 11) | 20) & 0xFu; }
#define XB_SPIN(cond, bar) do { unsigned _sp = 0; while (cond) { __builtin_amdgcn_s_sleep(1); \
    if ((++_sp & 255u) == 0u) { if (xb_ld(&(bar)[XB_TMO])) break; if (_sp > XB_SPIN_CAP) { atomicAdd(&(bar)[XB_TMO], 1u); break; } } } } while (0)

struct XcdBarrier { unsigned* bar; unsigned x; volatile LAS unsigned* st; };

__device__ __forceinline__ XcdBarrier xcd_barrier_post(unsigned* bar, volatile LAS unsigned* st) {
    XcdBarrier b; b.bar = bar; b.x = xb_xcc_id(); b.st = st;
    if (threadIdx.x == 0) (void)xb_add(&bar[XB_XCNT(b.x)], 1u);
    return b;
}
__device__ __forceinline__ void xcd_barrier_complete(unsigned* bar, unsigned x, unsigned& nloc, unsigned& nx) {
    const unsigned G = gridDim.x * gridDim.y * gridDim.z;
    unsigned sum, cnt, mine, sp = 0u;
    for (;;) {
        sum = 0u; cnt = 0u; mine = 0u;
#pragma unroll
        for (unsigned j = 0; j < 16; ++j) { const unsigned c = xb_ld(&bar[XB_XCNT(j)]); sum += c; cnt += (c > 0u) ? 1u : 0u; mine = (j == x) ? c : mine; }
        if (sum == G) break;
        __builtin_amdgcn_s_sleep(1);
        if ((++sp & 255u) == 0u) { if (xb_ld(&bar[XB_TMO])) break; if (sp > XB_SPIN_CAP) { atomicAdd(&bar[XB_TMO], 1u); break; } }
    }
    nloc = mine > 0u ? mine : 1u; nx = cnt > 0u ? cnt : 1u;
}
__device__ __forceinline__ void xcd_barrier(const XcdBarrier& b) {
    asm volatile("s_waitcnt vmcnt(0)" ::: "memory");
    __syncthreads();
    if (threadIdx.x == 0) {
        unsigned* bar = b.bar;
        __builtin_amdgcn_s_waitcnt(0);
        unsigned nloc = b.st[0], nx = b.st[1];
        if (nloc == 0u) { xcd_barrier_complete(bar, b.x, nloc, nx); b.st[0] = nloc; b.st[1] = nx; }
        const unsigned old = xb_add(&bar[XB_XSUB(b.x)], 1u);
        const unsigned gen = old / nloc;
        if (old + 1u == (gen + 1u) * nloc) {
            __builtin_amdgcn_fence(__ATOMIC_RELEASE, "agent");
            asm volatile("s_waitcnt vmcnt(0)" ::: "memory");
            const unsigned og = xb_add(&bar[XB_TOP], 1u);
            const unsigned tg = og / nx;
            if (og + 1u == (tg + 1u) * nx) xb_add(&bar[XB_TOPGEN], 1u);
            else XB_SPIN(xb_ld(&bar[XB_TOPGEN]) == tg, bar);
            __builtin_amdgcn_fence(__ATOMIC_ACQUIRE, "agent");
            xb_add(&bar[XB_XGEN(b.x)], 1u);
            asm volatile("s_waitcnt vmcnt(0)" ::: "memory");
        } else {
            XB_SPIN(xb_ld(&bar[XB_XGEN(b.x)]) == gen, bar);
            __builtin_amdgcn_fence(__ATOMIC_ACQUIRE, "agent");
            asm volatile("s_waitcnt vmcnt(0)" ::: "memory");
        }
    }
    __syncthreads();
}

namespace pg8 {
constexpr int BM = 256, BK = 64, HALF = 128, HTB = HALF * BK * 2, STAGE_BYTES = 8 * HTB, NXCD = 8, WGM = 8;
__host__ __device__ __forceinline__ int lds_byte(int r, int c) { const int st = (r >> 4) * 2 + (c >> 5), rr = r & 15, cc = c & 31, ob = rr * 64 + cc * 2; return st * 1024 + (ob ^ (((ob >> 9) & 1) << 5)); }
__host__ __device__ __forceinline__ void stage_rc(int b, int& R, int& C) { const int st = b / 1024, sb = b % 1024, swz = sb ^ (((sb >> 9) & 1) << 5); R = (st >> 1) * 16 + swz / 64; C = (st & 1) * 32 + (swz % 64) / 2; }
__host__ __device__ __forceinline__ int perm32(int rho) { const int n = rho >> 4, i = rho & 15; return 8 * (i >> 2) + 4 * n + (i & 3); }

struct Unit { int pm, pn, thin, k0, sp; };
struct Gemm { const bf16_t* A; const bf16_t* Bt; int ktA, ktB, K; };

struct StaticOrder {
    int nM, nN, nwg, G, c, wgm;
    __device__ void init(int M, int N, int G_, int c_, int wgm_ = WGM) { nM = M / BM; nN = N / BM; nwg = nM * nN; G = G_; c = c_; wgm = wgm_; }
    __device__ bool next(int i, Unit& u) const {
        const long L = (long)i * G + c; if (L >= nwg) return false;
        int wgid = (int)L; { const int q = nwg / NXCD, r = nwg % NXCD, xcd = wgid % NXCD, off = wgid / NXCD; wgid = (xcd < r ? xcd * (q + 1) : r * (q + 1) + (xcd - r) * q) + off; }
        const int nig = wgm * nN, gid = wgid / nig, fm = gid * wgm, gsz = (nM - fm) < wgm ? (nM - fm) : wgm;
        u.pm = fm + ((wgid % nig) % gsz); u.pn = (wgid % nig) / gsz; u.thin = 0; u.k0 = 0; u.sp = 0; return true;
    }
};
struct TailOrder {
    int n, fixed, tmode, G, c;
    __device__ void init(int n_, int fixed_, int tmode_, int G_, int c_) { n = n_; fixed = fixed_; tmode = tmode_; G = G_; c = c_; }
    __device__ bool next(int i, Unit& u) const { const int L = i * G + c; if (L >= n) return false;
        if (tmode == 1) { u.pm = fixed; u.pn = L; u.thin = 1; } else { u.pm = L; u.pn = fixed; u.thin = 2; } u.k0 = 0; u.sp = 0; return true; }
};
struct SplitTailOrder {
    int n, nsplit, ktps, fixed, tmode, c;
    __device__ void init(int n_, int nsplit_, int ktps_, int fixed_, int tmode_, int c_) { n = n_; nsplit = nsplit_; ktps = ktps_; fixed = fixed_; tmode = tmode_; c = c_; }
    __device__ bool next(int i, Unit& u) const { if (i > 0) return false; const int q = c >> 3, slot = q / nsplit, sp = q - slot * nsplit, tile = slot * 8 + (c & 7); if (tile >= n) return false;
        if (tmode == 1) { u.pm = fixed; u.pn = tile; u.thin = 1; } else { u.pm = tile; u.pn = fixed; u.thin = 2; } u.k0 = sp * ktps; u.sp = sp; return true; }
};
struct BlockDiagOrder {
    int nwg, G, c;
    __device__ void init(int G_, int c_) { nwg = NG * 9; G = G_; c = c_; }
    __device__ bool next(int i, Unit& u) const { const int L = i * G + c; if (L >= nwg) return false;
        const int q = nwg / NXCD, r = nwg % NXCD, xcd = L % NXCD, off = L / NXCD; const int w = (xcd < r ? xcd * (q + 1) : r * (q + 1) + (xcd - r) * q) + off;
        u.pm = w; u.pn = w / 9; u.thin = 0; u.k0 = 0; u.sp = 0; return true; }
};

template <class Epi, class Sched, int THIN = 0>
__device__ __forceinline__ void gemm_phase(LAS unsigned char* lds, const Gemm g, const Sched& S, const Epi& E) {
    const int K = g.K, nt = K / BK;
    const int wid = __builtin_amdgcn_readfirstlane((int)threadIdx.x >> 6), wr = wid >> 2;
    unsigned voffA[2], voffB[2]; int aoff, boff;
#define PG8_LANE_SETUP() do { unsigned t_ = threadIdx.x; asm volatile("" : "+v"(t_)); const unsigned l_ = t_ & 63u, w_ = (unsigned)__builtin_amdgcn_readfirstlane((int)(t_ >> 6)); \
          \
        const unsigned swz_ = (l_ << 4) ^ ((l_ >> 5) << 5), R_ = (w_ >> 1) * 16u + (swz_ >> 6), Cl_ = (swz_ & 63u) >> 1, rho_ = R_ & 31u; \
        const unsigned Rb_ = Epi::PERM ? ((R_ & ~31u) + 8u * ((rho_ & 15u) >> 2) + 4u * (rho_ >> 4) + (rho_ & 3u)) : R_; \
        voffA[0] = ((w_ & 1u) * 8192u + R_ * 32u + Cl_) * 2u; voffA[1] = voffA[0] + 4096u; voffB[0] = ((w_ & 1u) * 8192u + Rb_ * 32u + Cl_) * 2u; voffB[1] = voffB[0] + 4096u; \
        const unsigned ob_ = (l_ & 15u) * 64u + (l_ >> 4) * 16u, lp_ = ob_ ^ (((l_ >> 3) & 1u) << 5); \
        aoff = (int)((w_ >> 2) * 8192u + lp_); boff = (int)((w_ & 3u) * 4096u + lp_); } while (0)
    PG8_LANE_SETUP();
    const size_t kstep = (size_t)32768;
    const size_t hstepA = (size_t)8192, hstepB = (size_t)8192;
    const size_t tstepA = (size_t)g.ktA * 32768, tstepB = (size_t)g.ktB * 32768;
    const unsigned ldsw = (unsigned)wid * 1024u;
#define PG8_SA(b, h) (((b) * 2 + (h)) * HTB)
#define PG8_SB(b, h) ((4 + (b) * 2 + (h)) * HTB)
#define PG8_STAGE(bufoff, gbase, voff) do { _Pragma("unroll") for (int _i = 0; _i < 2; ++_i) { unsigned keep_; \
        asm volatile("s_mov_b32 %0, m0\n\ts_mov_b32 m0, %3\n\ts_nop 0\n\tglobal_load_lds_dwordx4 %1, %2\n\ts_mov_b32 m0, %0" \
            : "=&s"(keep_) : "v"((voff)[_i]), "s"((const char*)(gbase)), "s"((unsigned)(size_t)(lds + (bufoff) + ldsw + _i * 8192)) : "memory"); } } while (0)
#define PG8_LDA(dst, b, h) do { if (THIN == 3) break; _Pragma("unroll") for (int m = 0; m < 4; ++m) _Pragma("unroll") for (int k = 0; k < 2; ++k) dst[m][k] = *(const LAS bf16x8*)(lds + PG8_SA(b, h) + aoff + m * 2048 + k * 1024); } while (0)
#define PG8_LDB(dst, b, h) do { if (THIN == 3) break; _Pragma("unroll") for (int n = 0; n < 2; ++n) _Pragma("unroll") for (int k = 0; k < 2; ++k) dst[n][k] = *(const LAS bf16x8*)(lds + PG8_SB(b, h) + boff + n * 2048 + k * 1024); } while (0)
#define PG8_MMA(ai, bj, At, Bt) do { if (THIN == 0 || ((mm >> ((ai) * 2 + (bj))) & 1)) { __builtin_amdgcn_s_setprio(1); _Pragma("unroll") for (int m = 0; m < 4; ++m) _Pragma("unroll") for (int n = 0; n < 2; ++n) _Pragma("unroll") for (int k = 0; k < 2; ++k) \
        acc[ai][bj][m][n] = __builtin_amdgcn_mfma_f32_16x16x32_bf16(Bt[n][k], At[m][k], acc[ai][bj][m][n], 0, 0, 0); __builtin_amdgcn_s_setprio(0); } } while (0)
#define PG8_MMAF(ai, bj, At, Bt) do { if (THIN == 0 && first) { __builtin_amdgcn_s_setprio(1); \
        _Pragma("unroll") for (int m = 0; m < 4; ++m) _Pragma("unroll") for (int n = 0; n < 2; ++n) acc[ai][bj][m][n] = __builtin_amdgcn_mfma_f32_16x16x32_bf16(Bt[n][0], At[m][0], (f32x4){0.f, 0.f, 0.f, 0.f}, 0, 0, 0); \
        _Pragma("unroll") for (int m = 0; m < 4; ++m) _Pragma("unroll") for (int n = 0; n < 2; ++n) acc[ai][bj][m][n] = __builtin_amdgcn_mfma_f32_16x16x32_bf16(Bt[n][1], At[m][1], acc[ai][bj][m][n], 0, 0, 0); \
        __builtin_amdgcn_s_setprio(0); } else PG8_MMA(ai, bj, At, Bt); } while (0)
#define PG8_MM(u) (THIN == 0 ? 0xF : (THIN == 3 ? 0x0 : (THIN == 1 ? (wr == 0 ? 0x3 : 0x0) : (((wid & 3) < 2) ? 0x5 : 0x0))))
#define PG8_WAIT_V(n) asm volatile("s_waitcnt vmcnt(" #n ")" ::: "memory")
#define PG8_WAIT_L(n) asm volatile("s_waitcnt lgkmcnt(" #n ")" ::: "memory")
#define PG8_BAR __builtin_amdgcn_s_barrier()
#define PG8_SCHED __builtin_amdgcn_sched_barrier(0)
    Unit cur, nxt; int ui = 0;
    if (!S.next(0, cur)) return;
    int mm = PG8_MM(cur);
    int pre_pm = -1, pre_buf = 0;
    if constexpr (Epi::PRE) { pre_buf ^= 1; E.pre(cur.pm, pre_buf); pre_pm = cur.pm; }
    f32x4 acc[2][2][4][2];
#pragma unroll
    for (int a = 0; a < 2; ++a)
#pragma unroll
        for (int b = 0; b < 2; ++b)
#pragma unroll
            for (int m = 0; m < 4; ++m)
#pragma unroll
                for (int n = 0; n < 2; ++n) { if (THIN == 0) asm volatile("" : "=v"(acc[a][b][m][n])); else acc[a][b][m][n] = (f32x4){0.f, 0.f, 0.f, 0.f}; }
    bf16x8 At[4][2] = {}, B0[2][2] = {}, B1[2][2] = {};
    const char* cA = (const char*)g.A + (size_t)cur.pm * tstepA + (size_t)cur.k0 * kstep; const char* cB = (const char*)g.Bt + (size_t)cur.pn * tstepB + (size_t)cur.k0 * kstep;
#define PG8_LEAN (THIN == 1)
#define PG8_WAIT_K() do { if (PG8_LEAN) PG8_WAIT_V(6); else PG8_WAIT_V(8); } while (0)
#define PG8_RD (!PG8_LEAN || wr == 0)
    PG8_STAGE(PG8_SB(0, 0), cB, voffB); PG8_STAGE(PG8_SB(0, 1), cB + hstepB, voffB); PG8_STAGE(PG8_SA(0, 0), cA, voffA); if (!PG8_LEAN) PG8_STAGE(PG8_SA(0, 1), cA + hstepA, voffA);
    if (wr == 1) PG8_BAR;
    if (PG8_LEAN) PG8_WAIT_V(0); else PG8_WAIT_V(2);
    PG8_BAR;
    PG8_STAGE(PG8_SB(1, 0), cB + kstep, voffB); PG8_STAGE(PG8_SA(1, 0), cA + kstep, voffA); PG8_STAGE(PG8_SB(1, 1), cB + hstepB + kstep, voffB);
    PG8_WAIT_V(6); PG8_BAR;
    for (;;) {
        const bool has_next = S.next(ui + 1, nxt);
        const char* nA = has_next ? (const char*)g.A + (size_t)nxt.pm * tstepA + (size_t)nxt.k0 * kstep : cA; const char* nB = has_next ? (const char*)g.Bt + (size_t)nxt.pn * tstepB + (size_t)nxt.k0 * kstep : cB;
        for (int t = 0; t < nt; t += 2) {
            const bool last = (t == nt - 2), first = (t == 0);
            const char* a1 = cA + (size_t)(t + 1) * kstep;
            const char* a2 = last ? nA : cA + (size_t)(t + 2) * kstep; const char* b2 = last ? nB : cB + (size_t)(t + 2) * kstep;
            const char* a3 = a2 + kstep; const char* b3 = b2 + kstep;
            if (PG8_RD) { PG8_LDB(B0, 0, 0); PG8_LDB(B1, 0, 1); PG8_SCHED; PG8_LDA(At, 0, 0); } if (!PG8_LEAN) PG8_STAGE(PG8_SA(1, 1), a1 + hstepA, voffA);
            PG8_WAIT_K(); PG8_WAIT_L(0); PG8_BAR; PG8_MMAF(0, 0, At, B0); PG8_MMAF(0, 1, At, B1); PG8_BAR; PG8_SCHED;
            if (!PG8_LEAN) PG8_LDA(At, 0, 1); PG8_STAGE(PG8_SB(0, 0), b2, voffB); PG8_STAGE(PG8_SB(0, 1), b2 + hstepB, voffB); PG8_STAGE(PG8_SA(0, 0), a2, voffA);
            PG8_WAIT_K(); PG8_WAIT_L(0); PG8_BAR; PG8_MMAF(1, 0, At, B0); PG8_MMAF(1, 1, At, B1); PG8_BAR; PG8_SCHED;
            if (PG8_RD) { PG8_LDB(B0, 1, 0); PG8_LDB(B1, 1, 1); PG8_SCHED; PG8_LDA(At, 1, 0); } if (!PG8_LEAN) PG8_STAGE(PG8_SA(0, 1), a2 + hstepA, voffA);
            PG8_WAIT_K(); PG8_WAIT_L(0); PG8_BAR; PG8_MMA(0, 0, At, B0); PG8_MMA(0, 1, At, B1); PG8_BAR; PG8_SCHED;
            if (!PG8_LEAN) PG8_LDA(At, 1, 1); PG8_STAGE(PG8_SB(1, 0), b3, voffB); PG8_STAGE(PG8_SB(1, 1), b3 + hstepB, voffB); PG8_STAGE(PG8_SA(1, 0), a3, voffA);
            PG8_WAIT_K(); PG8_WAIT_L(0); PG8_BAR; PG8_MMA(1, 0, At, B0); PG8_MMA(1, 1, At, B1); PG8_BAR; PG8_SCHED;
        }
        if constexpr (Epi::PRE) {
            int t_ = threadIdx.x; asm volatile("" : "+v"(t_)); const int l_ = t_ & 63, w_ = __builtin_amdgcn_readfirstlane(t_ >> 6);
            if (wr == 0) { E(acc, cur, w_ >> 2, w_ & 3, l_ & 15, l_ >> 4, pre_buf, 0, 1); PG8_BAR; E(acc, cur, w_ >> 2, w_ & 3, l_ & 15, l_ >> 4, pre_buf, 1, 2); }
            else E(acc, cur, w_ >> 2, w_ & 3, l_ & 15, l_ >> 4, pre_buf, 0, 2);
        } else {
        if (wr == 0) PG8_BAR;
        { int t_ = threadIdx.x; asm volatile("" : "+v"(t_)); const int l_ = t_ & 63, w_ = __builtin_amdgcn_readfirstlane(t_ >> 6);
          E(acc, cur, w_ >> 2, w_ & 3, l_ & 15, l_ >> 4); }
        }
        if (!has_next) break;
        if constexpr (Epi::PRE) { if (nxt.pm != pre_pm) { pre_buf ^= 1; E.pre(nxt.pm, pre_buf); pre_pm = nxt.pm; } }
        PG8_LANE_SETUP();
        if (THIN != 0) {
#pragma unroll
        for (int a = 0; a < 2; ++a)
#pragma unroll
            for (int b = 0; b < 2; ++b)
#pragma unroll
                for (int m = 0; m < 4; ++m)
#pragma unroll
                    for (int n = 0; n < 2; ++n) acc[a][b][m][n] = (f32x4){0.f, 0.f, 0.f, 0.f};
        }
        cur = nxt; cA = nA; cB = nB; ++ui; mm = PG8_MM(cur);
        if (wr == 1) PG8_BAR;
    }
    PG8_WAIT_V(0);
    PG8_BAR;
#undef PG8_LANE_SETUP
#undef PG8_LEAN
#undef PG8_WAIT_K
#undef PG8_RD
#undef PG8_MM
#undef PG8_SA
#undef PG8_SB
#undef PG8_STAGE
#undef PG8_LDA
#undef PG8_LDB
#undef PG8_MMA
#undef PG8_MMAF
#undef PG8_WAIT_V
#undef PG8_WAIT_L
#undef PG8_BAR
#undef PG8_SCHED
}

template <class Epi, class Sched>
__device__ __forceinline__ void gemm_phase2(LAS unsigned char* lds, const Gemm g, const Sched& S, const Epi& E) {
    const int K = g.K, nt = K / BK;
    const int wid = __builtin_amdgcn_readfirstlane((int)threadIdx.x >> 6), wr = wid >> 2;
    unsigned voffA[2], voffB[2]; int aoff, boff;
#define P2_LANE_SETUP() do { int t_ = threadIdx.x; asm volatile("" : "+v"(t_)); const int l_ = t_ & 63, w_ = __builtin_amdgcn_readfirstlane(t_ >> 6); \
        const int sb_ = l_ * 16, sw_ = sb_ ^ (((sb_ >> 9) & 1) << 5), rr_ = sw_ >> 6, cc_ = (sw_ & 63) >> 1; \
        _Pragma("unroll") for (int i = 0; i < 2; ++i) { const int R = 16 * (w_ + 8 * i) + rr_; const int Rb = Epi::PERM ? ((R & ~31) + perm32(R & 31)) : R; \
            voffA[i] = (unsigned)(R * 32 + cc_) * 2u; voffB[i] = (unsigned)(Rb * 32 + cc_) * 2u; } \
        const int ob_ = (l_ & 15) * 64 + (l_ >> 4) * 16, in_ = ob_ ^ (((ob_ >> 9) & 1) << 5); \
        aoff = (w_ >> 2) * 4096 + in_; boff = (w_ & 3) * 2048 + in_; } while (0)
    P2_LANE_SETUP();
    const size_t kstep = (size_t)32768;
    const size_t tstepA = (size_t)g.ktA * 32768, tstepB = (size_t)g.ktB * 32768;
    const unsigned ldsw = (unsigned)wid * 1024u;
#define P2_XA(b, kh) ((((b) * 2 + (kh)) * 2 + 0) * 16384)
#define P2_XB(b, kh) ((((b) * 2 + (kh)) * 2 + 1) * 16384)
#define P2_STAGE1(bufoff, gbase, voff) do { _Pragma("unroll") for (int _i = 0; _i < 2; ++_i) { unsigned keep_; \
        asm volatile("s_mov_b32 %0, m0\n\ts_mov_b32 m0, %3\n\ts_nop 0\n\tglobal_load_lds_dwordx4 %1, %2\n\ts_mov_b32 m0, %0" \
            : "=&s"(keep_) : "v"((voff)[_i]), "s"((const char*)(gbase)), "s"((unsigned)(size_t)(lds + (bufoff) + ldsw + _i * 8192)) : "memory"); } } while (0)
#define P2_STAGE(b, kh, ga, gb) do { P2_STAGE1(P2_XB(b, kh), (gb) + (kh) * 16384, voffB); P2_STAGE1(P2_XA(b, kh), (ga) + (kh) * 16384, voffA); } while (0)
#define P2_READ(b, kh) do { _Pragma("unroll") for (int bj = 0; bj < 2; ++bj) _Pragma("unroll") for (int n = 0; n < 2; ++n) Bf[bj][n] = *(const LAS bf16x8*)(lds + P2_XB(b, kh) + boff + (bj * 8 + n) * 1024); \
        __builtin_amdgcn_sched_barrier(0); \
        _Pragma("unroll") for (int ai = 0; ai < 2; ++ai) _Pragma("unroll") for (int m = 0; m < 4; ++m) Af[ai][m] = *(const LAS bf16x8*)(lds + P2_XA(b, kh) + aoff + (ai * 8 + m) * 1024); } while (0)
#define P2_MMA() do { __builtin_amdgcn_s_setprio(1); _Pragma("unroll") for (int ai = 0; ai < 2; ++ai) _Pragma("unroll") for (int bj = 0; bj < 2; ++bj) _Pragma("unroll") for (int m = 0; m < 4; ++m) _Pragma("unroll") for (int n = 0; n < 2; ++n) \
        acc[ai][bj][m][n] = __builtin_amdgcn_mfma_f32_16x16x32_bf16(Bf[bj][n], Af[ai][m], acc[ai][bj][m][n], 0, 0, 0); __builtin_amdgcn_s_setprio(0); } while (0)
#define P2_WAIT_V(n) asm volatile("s_waitcnt vmcnt(" #n ")" ::: "memory")
#define P2_WAIT_L0() asm volatile("s_waitcnt lgkmcnt(0)" ::: "memory")
#define P2_BAR __builtin_amdgcn_s_barrier()
#define P2_SCHED __builtin_amdgcn_sched_barrier(0)
    Unit cur, nxt; int ui = 0;
    if (!S.next(0, cur)) return;
    f32x4 acc[2][2][4][2];
#pragma unroll
    for (int a = 0; a < 2; ++a)
#pragma unroll
        for (int b = 0; b < 2; ++b)
#pragma unroll
            for (int m = 0; m < 4; ++m)
#pragma unroll
                for (int n = 0; n < 2; ++n) acc[a][b][m][n] = (f32x4){0.f, 0.f, 0.f, 0.f};
    bf16x8 Af[2][4], Bf[2][2];
    const char* cA = (const char*)g.A + (size_t)cur.pm * tstepA + (size_t)cur.k0 * kstep; const char* cB = (const char*)g.Bt + (size_t)cur.pn * tstepB + (size_t)cur.k0 * kstep;
    P2_STAGE(0, 0, cA, cB); P2_STAGE(0, 1, cA, cB);
    if (wr == 1) P2_BAR;
    P2_WAIT_V(4); P2_BAR;
    P2_STAGE(1, 0, cA + kstep, cB + kstep);
    P2_WAIT_V(8); P2_BAR;
    for (;;) {
        const bool has_next = S.next(ui + 1, nxt);
        const char* nA = has_next ? (const char*)g.A + (size_t)nxt.pm * tstepA + (size_t)nxt.k0 * kstep : cA; const char* nB = has_next ? (const char*)g.Bt + (size_t)nxt.pn * tstepB + (size_t)nxt.k0 * kstep : cB;
        for (int t = 0; t < nt; t += 2) {
            const bool last = (t == nt - 2);
            const char* a1 = cA + (size_t)(t + 1) * kstep; const char* b1 = cB + (size_t)(t + 1) * kstep;
            const char* a2 = last ? nA : cA + (size_t)(t + 2) * kstep; const char* b2 = last ? nB : cB + (size_t)(t + 2) * kstep;
            const char* a3 = a2 + kstep; const char* b3 = b2 + kstep;
            P2_READ(0, 0); P2_STAGE(1, 1, a1, b1);
            P2_WAIT_V(8); P2_WAIT_L0(); P2_BAR; P2_MMA(); P2_BAR; P2_SCHED;
            P2_READ(0, 1); P2_STAGE(0, 0, a2, b2);
            P2_WAIT_V(8); P2_WAIT_L0(); P2_BAR; P2_MMA(); P2_BAR; P2_SCHED;
            P2_READ(1, 0); P2_STAGE(0, 1, a2, b2);
            P2_WAIT_V(8); P2_WAIT_L0(); P2_BAR; P2_MMA(); P2_BAR; P2_SCHED;
            P2_READ(1, 1); P2_STAGE(1, 0, a3, b3);
            P2_WAIT_V(8); P2_WAIT_L0(); P2_BAR; P2_MMA(); P2_BAR; P2_SCHED;
        }
        if (wr == 0) P2_BAR;
        { int t_ = threadIdx.x; asm volatile("" : "+v"(t_)); const int l_ = t_ & 63, w_ = __builtin_amdgcn_readfirstlane(t_ >> 6);
          E(acc, cur, w_ >> 2, w_ & 3, l_ & 15, l_ >> 4); }
        if (!has_next) break;
        P2_LANE_SETUP();
#pragma unroll
        for (int a = 0; a < 2; ++a)
#pragma unroll
            for (int b = 0; b < 2; ++b)
#pragma unroll
                for (int m = 0; m < 4; ++m)
#pragma unroll
                    for (int n = 0; n < 2; ++n) acc[a][b][m][n] = (f32x4){0.f, 0.f, 0.f, 0.f};
        cur = nxt; cA = nA; cB = nB; ++ui;
        if (wr == 1) P2_BAR;
    }
    P2_WAIT_V(0);
    P2_BAR;
#undef P2_LANE_SETUP
#undef P2_XA
#undef P2_XB
#undef P2_STAGE1
#undef P2_STAGE
#undef P2_READ
#undef P2_MMA
#undef P2_WAIT_V
#undef P2_WAIT_L0
#undef P2_BAR
#undef P2_SCHED
}
}
using pg8::Unit;


struct EpiSwiGLU {
    static constexpr bool PERM = true;
    static constexpr bool PRE = true;
    bf16_t* act; const float* ss; int nparts; LAS unsigned char* lds;
    __device__ __forceinline__ void pre(int pm, int buf) const {
        int t = threadIdx.x; asm volatile("" : "+v"(t));
        if (t < 256) { const int np = nparts < 0 ? 8 : nparts; const f32x4* p = (const f32x4*)(ss + (size_t)(pm * 256 + t) * 16);
            const f32x4 a = p[0], b = p[1]; float sq = (a.x + a.y) + (a.z + a.w) + (b.x + b.y) + (b.z + b.w);
            if (np > 8) { const f32x4 c = p[2], d = p[3]; sq += (c.x + c.y) + (c.z + c.w) + (d.x + d.y) + (d.z + d.w); }
            const float ms = sq * (1.0f / D) + RMS_EPS;
            ((LAS f32x2*)(lds + INVC_OFF))[buf * 256 + t] = (f32x2){rsqrtf(ms), ms}; }
    }
    __device__ __forceinline__ void operator()(const f32x4 (&acc)[2][2][4][2], const Unit& u, int wr, int wc, int fr, int fq, int buf, int ai_lo, int ai_hi) const {
        if (PROBE_EMPTY_EPI && nparts < 0) return;
        const int row0 = u.pm * 256 + wr * 64 + fr, col0 = u.pn * 128 + wc * 32 + 8 * fq;
        const LAS f32x2* ic = (const LAS f32x2*)(lds + INVC_OFF) + buf * 256 + wr * 64 + fr;
#pragma unroll
        for (int ai = 0; ai < 2; ++ai)
#pragma unroll
            for (int m = 0; m < 4; ++m) {
                if (ai < ai_lo || ai >= ai_hi) continue;
                if (u.thin == 1 && (wr | ai)) continue;
                const int r = row0 + ai * 128 + m * 16; const f32x2 iv = ic[ai * 128 + m * 16];
                const float c1 = -LOG2E * iv.x; const f32x2 c1v = {c1, c1}, msv = {iv.y, iv.y};
                f32x2 o[4];
#pragma unroll
                for (int n = 0; n < 2; ++n)
#pragma unroll
                    for (int jp = 0; jp < 2; ++jp) {
                        const f32x2 g = {acc[ai][0][m][n][2 * jp], acc[ai][0][m][n][2 * jp + 1]}, up = {acc[ai][1][m][n][2 * jp], acc[ai][1][m][n][2 * jp + 1]};
                        const f32x2 t = g * c1v; const f32x2 e = {fast_exp2(t.x), fast_exp2(t.y)}; const f32x2 d = e * msv + msv; const f32x2 rc = {fast_rcp(d.x), fast_rcp(d.y)};
                        o[n * 2 + jp] = (g * up) * rc;
                    }
                u32x4 w; w.x = cvt_pk_bf16(o[0].x, o[0].y); w.y = cvt_pk_bf16(o[1].x, o[1].y); w.z = cvt_pk_bf16(o[2].x, o[2].y); w.w = cvt_pk_bf16(o[3].x, o[3].y);
                __builtin_nontemporal_store(w, (u32x4*)(act + blk(r, col0, DFF / 64)));
            }
    }
};

struct EpiResid {
    static constexpr bool PRE = false;
    static constexpr bool PERM = true;
    bf16_t* hb; float* ss; float scale; LAS float* red;
    __device__ __forceinline__ void operator()(const f32x4 (&acc)[2][2][4][2], const Unit& u, int wr, int wc, int fr, int fq) const {
        if (PROBE_EMPTY_EPI && scale == 0.0f) return;
        const int row0 = u.pm * 256 + wr * 64 + fr, col0 = u.pn * 256 + wc * 32 + 8 * fq;
        float rs[2][4];
#pragma unroll
        for (int ai = 0; ai < 2; ++ai) {
            if (u.thin == 1 && (wr | ai)) {
#pragma unroll
                for (int m = 0; m < 4; ++m) rs[ai][m] = 0.f;
                continue; }
            u32x4 hv[4][2];
#pragma unroll
            for (int m = 0; m < 4; ++m)
#pragma unroll
                for (int bj = 0; bj < 2; ++bj) hv[m][bj] = *(const u32x4*)(hb + blk(row0 + ai * 128 + m * 16, col0 + bj * 128, D / 64));
#pragma unroll
            for (int m = 0; m < 4; ++m) {
                const int ri = row0 + ai * 128 + m * 16; float s = 0.f;
#pragma unroll
                for (int bj = 0; bj < 2; ++bj) {
                    bf16_t* bp = hb + blk(ri, col0 + bj * 128, D / 64);
                    f32x4 v0, v1; unpack8(hv[m][bj], v0, v1);
                    v0 += scale * acc[ai][bj][m][0]; v1 += scale * acc[ai][bj][m][1];
                    u32x4 w; w.x = cvt_pk_bf16(v0[0], v0[1]); w.y = cvt_pk_bf16(v0[2], v0[3]); w.z = cvt_pk_bf16(v1[0], v1[1]); w.w = cvt_pk_bf16(v1[2], v1[3]);
                    *(u32x4*)bp = w;
                    s += (v0[0] * v0[0] + v0[1] * v0[1]) + (v0[2] * v0[2] + v0[3] * v0[3]) + (v1[0] * v1[0] + v1[1] * v1[1]) + (v1[2] * v1[2] + v1[3] * v1[3]);
                }
                rs[ai][m] = s;
            }
        }
#pragma unroll
        for (int ai = 0; ai < 2; ++ai)
#pragma unroll
            for (int m = 0; m < 4; ++m) { float s = rs[ai][m]; s += __shfl_xor(s, 16); s += __shfl_xor(s, 32); if (fq == 0) red[(ai * 128 + wr * 64 + m * 16 + fr) * 4 + wc] = s; }
        asm volatile("s_waitcnt lgkmcnt(0)" ::: "memory"); __builtin_amdgcn_s_barrier(); asm volatile("" ::: "memory");
        const int tid = (wr * 4 + wc) * 64 + fq * 16 + fr;
        if (tid < (u.thin == 1 ? 64 : 256)) { const f32x4 v = *(const LAS f32x4*)(red + tid * 4); ss[(size_t)(u.pm * 256 + tid) * 16 + u.pn] = (v.x + v.y) + (v.z + v.w); }
    }
};

struct EpiGLU {
    static constexpr bool PRE = false;
    static constexpr bool PERM = true;
    bf16_t* hb; float* ss; float scale; LAS float* red;
    __device__ __forceinline__ void operator()(const f32x4 (&acc)[2][2][4][2], const Unit& u, int wr, int wc, int fr, int fq) const {
        const int row0 = u.pm * 256 + wr * 64 + fr, col0 = u.pn * 128 + wc * 32 + 8 * fq;
        float rs[2][4];
#pragma unroll
        for (int ai = 0; ai < 2; ++ai) {
            if (u.thin == 1 && (wr | ai)) {
#pragma unroll
                for (int m = 0; m < 4; ++m) rs[ai][m] = 0.f;
                continue; }
            u32x4 hv[4];
#pragma unroll
            for (int m = 0; m < 4; ++m) hv[m] = *(const u32x4*)(hb + blk(row0 + ai * 128 + m * 16, col0, D / 64));
#pragma unroll
            for (int m = 0; m < 4; ++m) {
                const int ri = row0 + ai * 128 + m * 16; bf16_t* bp = hb + blk(ri, col0, D / 64);
                f32x4 v0, v1; unpack8(hv[m], v0, v1);
#pragma unroll
                for (int j = 0; j < 4; ++j) { v0[j] += scale * acc[ai][0][m][0][j] * sigmoidf_(acc[ai][1][m][0][j]); v1[j] += scale * acc[ai][0][m][1][j] * sigmoidf_(acc[ai][1][m][1][j]); }
                u32x4 w; w.x = cvt_pk_bf16(v0[0], v0[1]); w.y = cvt_pk_bf16(v0[2], v0[3]); w.z = cvt_pk_bf16(v1[0], v1[1]); w.w = cvt_pk_bf16(v1[2], v1[3]);
                *(u32x4*)bp = w;
                rs[ai][m] = (v0[0] * v0[0] + v0[1] * v0[1]) + (v0[2] * v0[2] + v0[3] * v0[3]) + (v1[0] * v1[0] + v1[1] * v1[1]) + (v1[2] * v1[2] + v1[3] * v1[3]);
            }
        }
#pragma unroll
        for (int ai = 0; ai < 2; ++ai)
#pragma unroll
            for (int m = 0; m < 4; ++m) { float s = rs[ai][m]; s += __shfl_xor(s, 16); s += __shfl_xor(s, 32); if (fq == 0) red[(ai * 128 + wr * 64 + m * 16 + fr) * 4 + wc] = s; }
        asm volatile("s_waitcnt lgkmcnt(0)" ::: "memory"); __builtin_amdgcn_s_barrier(); asm volatile("" ::: "memory");
        const int tid = (wr * 4 + wc) * 64 + fq * 16 + fr;
        if (tid < (u.thin == 1 ? 64 : 256)) { const f32x4 v = *(const LAS f32x4*)(red + tid * 4); ss[(size_t)(u.pm * 256 + tid) * 16 + u.pn] = (v.x + v.y) + (v.z + v.w); }
    }
};

struct EpiQK {
    static constexpr bool PRE = false;
    static constexpr bool PERM = true;
    bf16_t* qk; const float* ss; int nparts; const float* ropec; const float* ropes; float qscale;
    __device__ __forceinline__ void operator()(const f32x4 (&acc)[2][2][4][2], const Unit& u, int wr, int wc, int fr, int fq) const {
        const int row0 = u.pm * 256 + wr * 64 + fr;
        const int which = wc >> 1, i0 = 32 * (wc & 1) + 8 * fq;
        const int head = 2 * u.pn + which;
        float inv8[2][4]; row_inv8(ss, nparts, row0, fq, inv8);
        const float sc = __builtin_bit_cast(float, __builtin_amdgcn_readfirstlane(u.pn < 8 ? __builtin_bit_cast(int, qscale) : 0x3f800000));
#pragma unroll
        for (int ai = 0; ai < 2; ++ai)
#pragma unroll
            for (int mp = 0; mp < 4; mp += 2) {
                if (u.thin == 1 && (wr | ai)) continue;
                f32x4 cs[2][4];
#pragma unroll
                for (int q = 0; q < 2; ++q) { const int pos = row_pos(row0 + ai * 128 + (mp + q) * 16);
                    cs[q][0] = *(const f32x4*)(ropec + pos * 64 + i0); cs[q][1] = *(const f32x4*)(ropec + pos * 64 + i0 + 4);
                    cs[q][2] = *(const f32x4*)(ropes + pos * 64 + i0); cs[q][3] = *(const f32x4*)(ropes + pos * 64 + i0 + 4); }
#pragma unroll
                for (int q = 0; q < 2; ++q) {
                    const int m = mp + q, r = row0 + ai * 128 + m * 16; const float inv = inv8[ai][m] * sc;
                    const f32x4 c0 = cs[q][0], c1 = cs[q][1], s0 = cs[q][2], s1 = cs[q][3];
                    float o1[8], o2[8];
#pragma unroll
                    for (int j = 0; j < 4; ++j) {
                        const float xa = acc[ai][0][m][0][j] * inv, xb = acc[ai][1][m][0][j] * inv; o1[j] = xa * c0[j] - xb * s0[j]; o2[j] = xb * c0[j] + xa * s0[j];
                        const float ya = acc[ai][0][m][1][j] * inv, yb = acc[ai][1][m][1][j] * inv; o1[4 + j] = ya * c1[j] - yb * s1[j]; o2[4 + j] = yb * c1[j] + ya * s1[j];
                    }
                    bf16_t* op = qk + (size_t)r * QKLD + head * 128 + i0;
                    u32x4 w; w.x = cvt_pk_bf16(o1[0], o1[1]); w.y = cvt_pk_bf16(o1[2], o1[3]); w.z = cvt_pk_bf16(o1[4], o1[5]); w.w = cvt_pk_bf16(o1[6], o1[7]);
                    *(u32x4*)(op) = w;
                    w.x = cvt_pk_bf16(o2[0], o2[1]); w.y = cvt_pk_bf16(o2[2], o2[3]); w.z = cvt_pk_bf16(o2[4], o2[5]); w.w = cvt_pk_bf16(o2[6], o2[7]);
                    *(u32x4*)(op + 64) = w;
                }
            }
    }
};

struct EpiVt {
    static constexpr bool PRE = false;
    static constexpr bool PERM = true;
    bf16_t* vt; const float* ss; int nparts;
    __device__ __forceinline__ void operator()(const f32x4 (&acc)[2][2][4][2], const Unit& u, int wr, int wc, int fr, int fq) const {
        const int row0 = u.pm * 256 + wr * 64 + fr, col0 = u.pn * 256 + wc * 32 + 8 * fq;
#pragma unroll
        for (int bj = 0; bj < 2; ++bj) {
            if (u.thin == 2 && (bj | (wc >> 1))) continue;
            float inv[8];
            {
                const f32x4* p = (const f32x4*)(ss + (size_t)(col0 + bj * 128) * 16);
#pragma unroll
                for (int jb = 0; jb < 8; jb += 4) {
                    f32x4 q[4][4];
#pragma unroll
                    for (int j = 0; j < 4; ++j)
#pragma unroll
                        for (int x = 0; x < 4; ++x) q[j][x] = p[(jb + j) * 4 + x];
#pragma unroll
                    for (int j = 0; j < 4; ++j) { float sa = (q[j][0].x + q[j][0].y) + (q[j][0].z + q[j][0].w) + (q[j][1].x + q[j][1].y) + (q[j][1].z + q[j][1].w);
                        const float xa = (q[j][2].x + q[j][2].y) + (q[j][2].z + q[j][2].w) + (q[j][3].x + q[j][3].y) + (q[j][3].z + q[j][3].w);
                        sa += nparts > 8 ? xa : 0.f; inv[jb + j] = rsqrtf(sa * (1.0f / D) + RMS_EPS); }
                }
            }
#pragma unroll
            for (int ai = 0; ai < 2; ++ai)
#pragma unroll
                for (int m = 0; m < 4; ++m) {
                    const int r = row0 + ai * 128 + m * 16;
                    const f32x4 a = acc[ai][bj][m][0], b = acc[ai][bj][m][1];
                    u32x4 w; w.x = cvt_pk_bf16(a[0] * inv[0], a[1] * inv[1]); w.y = cvt_pk_bf16(a[2] * inv[2], a[3] * inv[3]); w.z = cvt_pk_bf16(b[0] * inv[4], b[1] * inv[5]); w.w = cvt_pk_bf16(b[2] * inv[6], b[3] * inv[7]);
                    *(u32x4*)(vt + (size_t)r * MPAD + col0 + bj * 128) = w;
                }
        }
    }
};

struct EpiSloc {
    static constexpr bool PRE = false;
    static constexpr bool PERM = true;
    bf16_t* C;
    __device__ __forceinline__ void operator()(const f32x4 (&acc)[2][2][4][2], const Unit& u, int wr, int wc, int fr, int fq) const {
        const int row0 = u.pm * 256 + wr * 64 + fr, col0 = wc * 32 + 8 * fq;
#pragma unroll
        for (int ai = 0; ai < 2; ++ai)
#pragma unroll
            for (int m = 0; m < 4; ++m) { bf16_t* rowp = C + (size_t)(row0 + ai * 128 + m * 16) * 256 + col0;
#pragma unroll
                for (int bj = 0; bj < 2; ++bj) { const f32x4 v0 = acc[ai][bj][m][0], v1 = acc[ai][bj][m][1];
                    u32x4 w; w.x = cvt_pk_bf16(v0[0], v0[1]); w.y = cvt_pk_bf16(v0[2], v0[3]); w.z = cvt_pk_bf16(v1[0], v1[1]); w.w = cvt_pk_bf16(v1[2], v1[3]);
                    *(u32x4*)(rowp + bj * 128) = w; } }
    }
};

struct EpiY {
    static constexpr bool PRE = false;
    static constexpr bool PERM = true;
    bf16_t* z;
    __device__ __forceinline__ void operator()(const f32x4 (&acc)[2][2][4][2], const Unit& u, int wr, int wc, int fr, int fq) const {
        const int g = u.pn, crow0 = (u.pm - 9 * g) * 256 + wr * 64 + fr;
#pragma unroll
        for (int ai = 0; ai < 2; ++ai)
#pragma unroll
            for (int m = 0; m < 4; ++m) {
                const int cr = crow0 + ai * 128 + m * 16;
                if (cr < NCH) {
#pragma unroll
                    for (int bj = 0; bj < 2; ++bj) {
                        const int ncol = 128 * bj + 32 * wc + 8 * fq, t = ncol >> 4, hh = ncol & 15;
                        constexpr float K0 = -1.5957691216057308f * LOG2E, K1 = K0 * 0.044715f;
                        const f32x2 k0v = {K0, K0}, k1v = {K1, K1}, one = {1.0f, 1.0f};
                        f32x2 o[4];
#pragma unroll
                        for (int n = 0; n < 2; ++n)
#pragma unroll
                            for (int jp = 0; jp < 2; ++jp) {
                                const f32x2 y = {acc[ai][bj][m][n][2 * jp], acc[ai][bj][m][n][2 * jp + 1]};
                                const f32x2 t = (y * y * k1v + k0v) * y; const f32x2 e = {fast_exp2(t.x), fast_exp2(t.y)}; const f32x2 d = e + one; const f32x2 rc = {fast_rcp(d.x), fast_rcp(d.y)};
                                o[n * 2 + jp] = y * rc;
                            }
                        u32x4 w; w.x = cvt_pk_bf16(o[0].x, o[0].y); w.y = cvt_pk_bf16(o[1].x, o[1].y); w.z = cvt_pk_bf16(o[2].x, o[2].y); w.w = cvt_pk_bf16(o[3].x, o[3].y);
                        *(u32x4*)(z + blk(chunk_tok_row(cr, t), g * 16 + hh, D / 64)) = w;
                    }
                }
            }
    }
};

template <class Epi, int TM> struct EpiSplit {
    static constexpr bool PRE = false;
    static constexpr bool PERM = Epi::PERM;
    Epi inner; float* part; unsigned* tick; int nsplit; volatile LAS unsigned* flag;
    __device__ __forceinline__ void operator()(const f32x4 (&acc)[2][2][4][2], const Unit& u, int wr, int wc, int fr, int fq) const {
        const int tile = TM == 1 ? u.pn : u.pm, lane = fq * 16 + fr;
        const bool holder = TM == 1 ? (wr == 0) : (wc < 2);
        const int w4 = TM == 1 ? wc : wr * 2 + wc;
        const __amdgpu_buffer_rsrc_t rs = __builtin_amdgcn_make_buffer_rsrc((void*)part, 0, 176 * 65536, 0x00020000);
        if (holder) {
            const unsigned off = (unsigned)(((tile * nsplit + u.sp) * 4 + w4) * 16384 + lane * 16);
#pragma unroll
            for (int x = 0; x < 2; ++x)
#pragma unroll
                for (int m = 0; m < 4; ++m)
#pragma unroll
                    for (int n = 0; n < 2; ++n) { const f32x4 v = TM == 1 ? acc[0][x][m][n] : acc[x][0][m][n];
                        __builtin_amdgcn_raw_buffer_store_b128(__builtin_bit_cast(u32x4, v), rs, off + (unsigned)((x * 8 + m * 2 + n) * 1024), 0, 16); }
        }
        asm volatile("s_waitcnt vmcnt(0)" ::: "memory"); __builtin_amdgcn_s_barrier(); asm volatile("" ::: "memory");
        if (wr == 0 && wc == 0 && lane == 0) { const unsigned old = __hip_atomic_fetch_add(tick + tile * 16, 1u, __ATOMIC_RELAXED, __HIP_MEMORY_SCOPE_AGENT); flag[0] = old; }
        asm volatile("s_waitcnt vmcnt(0) lgkmcnt(0)" ::: "memory"); __builtin_amdgcn_s_barrier(); asm volatile("" ::: "memory");
        const bool last = (int)(flag[0] % (unsigned)nsplit) == nsplit - 1;
        if (!last) return;
        __builtin_amdgcn_fence(__ATOMIC_ACQUIRE, "agent");
        asm volatile("s_waitcnt vmcnt(0)" ::: "memory");
        f32x4 acc2[2][2][4][2];
#pragma unroll
        for (int a = 0; a < 2; ++a)
#pragma unroll
            for (int b = 0; b < 2; ++b)
#pragma unroll
                for (int m = 0; m < 4; ++m)
#pragma unroll
                    for (int n = 0; n < 2; ++n) acc2[a][b][m][n] = (f32x4){0.f, 0.f, 0.f, 0.f};
        if (holder) {
            const float* p0 = part + (size_t)((tile * nsplit * 4 + w4) * 4096 + lane * 4);
            f32x4 va[16], vb[16];
#define ES_LOAD(dst, sp_) do { const float* p_ = p0 + (size_t)(sp_) * 16384; _Pragma("unroll") for (int i = 0; i < 16; ++i) dst[i] = *(const f32x4*)(p_ + i * 256); } while (0)
#define ES_ADD(src) do { _Pragma("unroll") for (int x = 0; x < 2; ++x) _Pragma("unroll") for (int m = 0; m < 4; ++m) _Pragma("unroll") for (int n = 0; n < 2; ++n) { \
            if (TM == 1) acc2[0][x][m][n] += src[x * 8 + m * 2 + n]; else acc2[x][0][m][n] += src[x * 8 + m * 2 + n]; } } while (0)
#pragma unroll 1
            for (int sp = 0; sp < nsplit; sp += 2) {
                asm volatile("" ::: "memory");
                const int spb = sp + 1 < nsplit ? sp + 1 : sp;
                ES_LOAD(va, sp); ES_LOAD(vb, spb);
                ES_ADD(va);
                if (sp + 1 < nsplit) ES_ADD(vb);
            }
#undef ES_LOAD
#undef ES_ADD
        }
        Unit u2 = u; u2.k0 = 0; u2.sp = 0; u2.thin = TM;
        inner(acc2, u2, wr, wc, fr, fq);
    }
};

struct Ctx { LAS unsigned char* lds; int tid, lane, wave, G, c; };
__device__ __forceinline__ Ctx fresh(const Ctx& F) { Ctx R = F; int t = threadIdx.x; asm volatile("" : "+v"(t)); R.tid = t; R.lane = t & 63; return R; }

__device__ __forceinline__ void tail_core(const bf16_t* At, int ktA, const bf16_t* W, int ktW, int rowa, int rowb, int ks0, int nks, int lane, f32x4 (&acc)[3][2]) {
    const int fr = lane & 15, fq = lane >> 4;
    const bf16_t* pa = At + ((size_t)((NREAL >> 8) * ktA) << 14) + (size_t)fr * 32 + 8 * fq;
    const bf16_t* pb0 = W + ((size_t)((rowa >> 8) * ktW) << 14) + (size_t)((rowa & 255) + fr) * 32 + 8 * fq;
    const bf16_t* pb1 = W + ((size_t)((rowb >> 8) * ktW) << 14) + (size_t)((rowb & 255) + fr) * 32 + 8 * fq;
#pragma unroll 4
    for (int ks = ks0; ks < ks0 + nks; ++ks) {
        const size_t ko = ((size_t)(ks >> 1) << 14) + (size_t)(ks & 1) * 8192;
        const bf16x8 a0 = *(const bf16x8*)(pa + ko), a1 = *(const bf16x8*)(pa + ko + 512), a2 = *(const bf16x8*)(pa + ko + 1024);
        const bf16x8 b0 = *(const bf16x8*)(pb0 + ko), b1 = *(const bf16x8*)(pb1 + ko);
        acc[0][0] = __builtin_amdgcn_mfma_f32_16x16x32_bf16(b0, a0, acc[0][0], 0, 0, 0); acc[0][1] = __builtin_amdgcn_mfma_f32_16x16x32_bf16(b1, a0, acc[0][1], 0, 0, 0);
        acc[1][0] = __builtin_amdgcn_mfma_f32_16x16x32_bf16(b0, a1, acc[1][0], 0, 0, 0); acc[1][1] = __builtin_amdgcn_mfma_f32_16x16x32_bf16(b1, a1, acc[1][1], 0, 0, 0);
        acc[2][0] = __builtin_amdgcn_mfma_f32_16x16x32_bf16(b0, a2, acc[2][0], 0, 0, 0); acc[2][1] = __builtin_amdgcn_mfma_f32_16x16x32_bf16(b1, a2, acc[2][1], 0, 0, 0);
    }
}
constexpr int TAIL_LDS_INV = 0, TAIL_LDS_PART = 1024;
__device__ __forceinline__ void tail_inv48(const Ctx& F, const float* sst, int ntp) {
    LAS float* inv48 = (LAS float*)(F.lds + TAIL_LDS_INV);
    float v[6];
#pragma unroll
    for (int i = 0; i < 6; ++i) { const int row = F.wave * 6 + i; const float a = F.lane < ntp ? sst[row * 128 + F.lane] : 0.f, b = F.lane + 64 < ntp ? sst[row * 128 + 64 + F.lane] : 0.f; v[i] = a + b; }
#pragma unroll
    for (int i = 0; i < 6; ++i) { const float t = wave_sum(v[i]); if (F.lane == 0) inv48[F.wave * 6 + i] = rsqrtf(t * (1.0f / D) + RMS_EPS); }
    __syncthreads();
}
template <int S, class Map, class Epi>
__device__ __forceinline__ void tail_gemm(const Ctx& F, const bf16_t* At, int ktA, const bf16_t* W, int ktW, int K, int ntasks, const Map& map, const Epi& epi) {
    constexpr int TPC = 8 / S;
    LAS float* part = (LAS float*)(F.lds + TAIL_LDS_PART);
    const int sub = F.wave / S, sp = F.wave - sub * S, nks = K / 32 / S;
    for (int base = F.c * TPC; base < ntasks; base += F.G * TPC) {
        const int task = base + sub; const bool valid = task < ntasks;
        f32x4 acc[3][2];
#pragma unroll
        for (int m = 0; m < 3; ++m) { acc[m][0] = (f32x4){0.f, 0.f, 0.f, 0.f}; acc[m][1] = (f32x4){0.f, 0.f, 0.f, 0.f}; }
        if (valid) { int ra, rb; map(task, ra, rb); tail_core(At, ktA, W, ktW, ra, rb, sp * nks, nks, F.lane, acc); }
        if (sp != 0) {
#pragma unroll
            for (int m = 0; m < 3; ++m)
#pragma unroll
                for (int t = 0; t < 2; ++t) *(LAS f32x4*)(part + ((F.wave * 6 + m * 2 + t) * 64 + F.lane) * 4) = acc[m][t];
        }
        __syncthreads();
        if (valid && sp == 0) {
#pragma unroll
            for (int s2 = 1; s2 < S; ++s2)
#pragma unroll
                for (int m = 0; m < 3; ++m)
#pragma unroll
                    for (int t = 0; t < 2; ++t) acc[m][t] += *(const LAS f32x4*)(part + (((F.wave + s2) * 6 + m * 2 + t) * 64 + F.lane) * 4);
            epi(task, acc, F.lane);
        }
        __syncthreads();
    }
}
struct TMapPair  { __device__ __forceinline__ void operator()(int task, int& ra, int& rb) const { const int j0 = 16 * task; ra = 256 * (j0 >> 7) + (j0 & 127); rb = ra + 128; } };
struct TMapPlain { __device__ __forceinline__ void operator()(int task, int& ra, int& rb) const { ra = 32 * task; rb = ra + 16; } };
struct TMapQK    { __device__ __forceinline__ void operator()(int task, int& ra, int& rb) const { const int head = task >> 2, i0 = 16 * (task & 3); ra = 256 * (head >> 1) + (head & 1) * 64 + i0; rb = ra + 128; } };
struct TEpiSwiGLU {
    bf16_t* act; const LAS float* inv48;
    __device__ __forceinline__ void operator()(int task, const f32x4 (&acc)[3][2], int lane) const {
        const int fr = lane & 15, fq = lane >> 4, j0 = 16 * task;
#pragma unroll
        for (int m = 0; m < 3; ++m) { const int tok = 16 * m + fr; const float inv = inv48[tok]; float o[4];
#pragma unroll
            for (int j = 0; j < 4; ++j) { const float gt = acc[m][0][j] * inv, up = acc[m][1][j] * inv; o[j] = gt * sigmoidf_(gt) * up; }
            u32x2 w; w.x = cvt_pk_bf16(o[0], o[1]); w.y = cvt_pk_bf16(o[2], o[3]);
            *(u32x2*)(act + blk(NREAL + tok, j0 + 4 * fq, DFF / 64)) = w; }
    }
};
struct TEpiResid {
    bf16_t* hb; float* sst; float scale;
    __device__ __forceinline__ void operator()(int task, const f32x4 (&acc)[3][2], int lane) const {
        const int fr = lane & 15, fq = lane >> 4;
        u32x2 hw[3][2];
#pragma unroll
        for (int m = 0; m < 3; ++m)
#pragma unroll
            for (int t = 0; t < 2; ++t) hw[m][t] = *(const u32x2*)(hb + blk(NREAL + 16 * m + fr, 32 * task + 16 * t + 4 * fq, D / 64));
#pragma unroll
        for (int m = 0; m < 3; ++m) { const int tok = 16 * m + fr; float s = 0.f;
#pragma unroll
            for (int t = 0; t < 2; ++t) { bf16_t* p = hb + blk(NREAL + tok, 32 * task + 16 * t + 4 * fq, D / 64); const u32x2 w0 = hw[m][t];
                f32x4 v; v[0] = __builtin_bit_cast(float, w0.x << 16); v[1] = __builtin_bit_cast(float, w0.x & 0xffff0000u); v[2] = __builtin_bit_cast(float, w0.y << 16); v[3] = __builtin_bit_cast(float, w0.y & 0xffff0000u);
                v += scale * acc[m][t];
                u32x2 w; w.x = cvt_pk_bf16(v[0], v[1]); w.y = cvt_pk_bf16(v[2], v[3]); *(u32x2*)p = w;
                s += (v[0] * v[0] + v[1] * v[1]) + (v[2] * v[2] + v[3] * v[3]); }
            s += __shfl_xor(s, 16); s += __shfl_xor(s, 32);
            if (fq == 0) sst[tok * 128 + task] = s; }
    }
};
struct TEpiGLU {
    bf16_t* hb; float* sst; float scale;
    __device__ __forceinline__ void operator()(int task, const f32x4 (&acc)[3][2], int lane) const {
        const int fr = lane & 15, fq = lane >> 4;
        u32x2 hw[3];
#pragma unroll
        for (int m = 0; m < 3; ++m) hw[m] = *(const u32x2*)(hb + blk(NREAL + 16 * m + fr, 16 * task + 4 * fq, D / 64));
#pragma unroll
        for (int m = 0; m < 3; ++m) { const int tok = 16 * m + fr;
            bf16_t* p = hb + blk(NREAL + tok, 16 * task + 4 * fq, D / 64); const u32x2 w0 = hw[m];
            f32x4 v; v[0] = __builtin_bit_cast(float, w0.x << 16); v[1] = __builtin_bit_cast(float, w0.x & 0xffff0000u); v[2] = __builtin_bit_cast(float, w0.y << 16); v[3] = __builtin_bit_cast(float, w0.y & 0xffff0000u);
#pragma unroll
            for (int j = 0; j < 4; ++j) v[j] += scale * acc[m][0][j] * sigmoidf_(acc[m][1][j]);
            u32x2 w; w.x = cvt_pk_bf16(v[0], v[1]); w.y = cvt_pk_bf16(v[2], v[3]); *(u32x2*)p = w;
            float s = (v[0] * v[0] + v[1] * v[1]) + (v[2] * v[2] + v[3] * v[3]);
            s += __shfl_xor(s, 16); s += __shfl_xor(s, 32);
            if (fq == 0) sst[tok * 128 + task] = s; }
    }
};
struct TEpiQK {
    bf16_t* qk; const LAS float* inv48; const float* ropec; const float* ropes; float qscale;
    __device__ __forceinline__ void operator()(int task, const f32x4 (&acc)[3][2], int lane) const {
        const int fr = lane & 15, fq = lane >> 4, head = task >> 2, i = 16 * (task & 3) + 4 * fq; const float sc = head < 16 ? qscale : 1.0f;
#pragma unroll
        for (int m = 0; m < 3; ++m) { const int tok = 16 * m + fr, pos = tok & 15; const float inv = inv48[tok] * sc;
            const f32x4 c = *(const f32x4*)(ropec + pos * 64 + i), sn = *(const f32x4*)(ropes + pos * 64 + i);
            float o1[4], o2[4];
#pragma unroll
            for (int j = 0; j < 4; ++j) { const float xa = acc[m][0][j] * inv, xb = acc[m][1][j] * inv; o1[j] = xa * c[j] - xb * sn[j]; o2[j] = xb * c[j] + xa * sn[j]; }
            bf16_t* op = qk + (size_t)(NREAL + tok) * QKLD + head * 128 + i;
            u32x2 w; w.x = cvt_pk_bf16(o1[0], o1[1]); w.y = cvt_pk_bf16(o1[2], o1[3]); *(u32x2*)op = w;
            w.x = cvt_pk_bf16(o2[0], o2[1]); w.y = cvt_pk_bf16(o2[2], o2[3]); *(u32x2*)(op + 64) = w; }
    }
};
struct TEpiVt {
    bf16_t* vt; const LAS float* inv48;
    __device__ __forceinline__ void operator()(int task, const f32x4 (&acc)[3][2], int lane) const {
        const int fr = lane & 15, fq = lane >> 4;
#pragma unroll
        for (int m = 0; m < 3; ++m) { const int tok = 16 * m + fr; const float inv = inv48[tok];
#pragma unroll
            for (int t = 0; t < 2; ++t)
#pragma unroll
                for (int j = 0; j < 4; j += 2) { const unsigned pk = cvt_pk_bf16(acc[m][t][j] * inv, acc[m][t][j + 1] * inv); bf16_t* p = vt + (size_t)(32 * task + 16 * t + 4 * fq + j) * MPAD + NREAL + tok;
                    p[0] = (bf16_t)(pk & 0xffffu); p[MPAD] = (bf16_t)(pk >> 16); } }
    }
};

__device__ __forceinline__ void transpose_item(const float* W, int K, int N, const float* gain, bf16_t* WT, int out_row0, LAS float* scr, int k0, int n0, int lane) {
    {
        const int n4 = (lane & 7) * 4, kr = lane >> 3;
        f32x4 v[8];
#pragma unroll
        for (int i = 0; i < 8; ++i) v[i] = *(const f32x4*)(W + (size_t)(k0 + kr + 8 * i) * N + n0 + n4);
#pragma unroll
        for (int i = 0; i < 8; ++i) { const int kk = kr + 8 * i; const float gk = gain ? gain[k0 + kk] : 1.0f; LAS float* d = scr + kk * 33 + n4;
            d[0] = v[i][0] * gk; d[1] = v[i][1] * gk; d[2] = v[i][2] * gk; d[3] = v[i][3] * gk; }
    }
    asm volatile("s_waitcnt lgkmcnt(0)" ::: "memory");
    const int c = lane & 7;
#pragma unroll
    for (int j = 0; j < 4; ++j) { const int n = (lane >> 3) + 8 * j; const LAS float* s = scr + (8 * c) * 33 + n;
        u32x4 o; o.x = cvt_pk_bf16(s[0 * 33], s[1 * 33]); o.y = cvt_pk_bf16(s[2 * 33], s[3 * 33]); o.z = cvt_pk_bf16(s[4 * 33], s[5 * 33]); o.w = cvt_pk_bf16(s[6 * 33], s[7 * 33]);
        *(u32x4*)(WT + blk(out_row0 + n, k0 + 8 * c, K >> 6)) = o; }
    asm volatile("s_waitcnt lgkmcnt(0)" ::: "memory");
}
__device__ __forceinline__ void transpose_matrix(const Ctx& F, const float* W, int K, int N, const float* gain, bf16_t* WT, bf16_t* WT2, int kind, int s0, int s1, int NS, int wave_lo) {
    if (F.wave < wave_lo) return;
    LAS float* scr = (LAS float*)(F.lds + F.wave * 16384);
    const int nblk = N / 32, nitems = (K / 64) * nblk;
    const int lo = (int)((long)nitems * s0 / NS), hi = (int)((long)nitems * s1 / NS);
    const int gw = (F.wave - wave_lo) * F.G + F.c, NGW = F.G * (8 - wave_lo);
    for (int it = lo + gw; it < hi; it += NGW) {
        const int kb = it / nblk, nb = it - kb * nblk, k0 = 64 * kb, n0 = 32 * nb;
        bf16_t* dst = WT; int row0;
        if (kind == 0) row0 = n0;
        else if (kind == 1) row0 = 256 * (n0 >> 7) + (n0 & 127);
        else if (kind == 2) row0 = 256 * (n0 >> 7) + 128 + (n0 & 127);
        else { if (n0 < 2560) { const int head = n0 >> 7, i0 = n0 & 127; row0 = 256 * (head >> 1) + ((i0 >= 64) ? 128 : 0) + (head & 1) * 64 + (i0 & 63); } else { dst = WT2; row0 = n0 - 2560; } }
        transpose_item(W, K, N, gain, dst, row0, scr, k0, n0, F.lane);
    }
}

__device__ __forceinline__ void phase_init(const Ctx& F, const float* xp, const float* xs, const float* meta, bf16_t* hb, float* ss, float* sst, float* ropec, float* ropes,
                                           const float* a_re, const float* a_im, const float* log_dt, const float* b_re, const float* b_im, float* s5t) {
    const int gw = F.c * 8 + F.wave, NGW = F.G * 8;
    for (int r = gw; r < MPAD; r += NGW) {
        const float* src = r < 16384 ? xp + (size_t)r * D : (r < NREAL ? xs + (size_t)(r - 16384) * D : (r < MVALID ? meta + (size_t)((r - NREAL) & 15) * D : nullptr));
        float part[8]; f32x4 xv[8];
#pragma unroll
        for (int j = 0; j < 8; ++j) xv[j] = src ? *(const f32x4*)(src + 256 * j + 4 * F.lane) : (f32x4){0.f, 0.f, 0.f, 0.f};
#pragma unroll
        for (int j = 0; j < 8; ++j) {
            const f32x4 v = xv[j];
            u32x2 w; w.x = cvt_pk_bf16(v[0], v[1]); w.y = cvt_pk_bf16(v[2], v[3]);
            *(u32x2*)(hb + blk(r, 256 * j + 4 * F.lane, D / 64)) = w;
            part[j] = wave_sum((v[0] * v[0] + v[1] * v[1]) + (v[2] * v[2] + v[3] * v[3]));
        }
        if (F.lane < 16) { float v = 0.f;
#pragma unroll
            for (int j = 0; j < 8; ++j) v = (F.lane == j) ? part[j] : v;
            ss[(size_t)r * 16 + F.lane] = v; }
        if (r >= NREAL && r < MVALID) { const float tot = ((part[0] + part[1]) + (part[2] + part[3])) + ((part[4] + part[5]) + (part[6] + part[7]));
            sst[(r - NREAL) * 128 + F.lane] = F.lane == 0 ? tot : 0.f; sst[(r - NREAL) * 128 + 64 + F.lane] = 0.f; }
    }
    {
        const int gw2 = F.c * 8 + F.wave, NGW2 = F.G * 8, i = F.lane;
        const double invf = exp2(-(double)i * (13.287712379549449 / 64.0));
        const double cd = cos(invf), sd = sin(invf);
        for (int pb = gw2; pb * 16 < 16400; pb += NGW2) {
            const int pos0 = pb * 16; const double a0 = (double)pos0 * invf;
            double c = cos(a0), sn = sin(a0);
            for (int k = 0; k < 16 && pos0 + k < 16400; ++k) {
                const int e = (pos0 + k) * 64 + i;
                ropec[e] = (float)c; ropes[e] = (float)sn;
                const double c2 = c * cd - sn * sd, s2 = sn * cd + c * sd; c = c2; sn = s2;
            }
        }
    }
    {
        const int gt = F.c * 512 + F.tid, NGT = F.G * 512;
        for (int e4 = gt; e4 < 4 * 2 * NG * 2 * 64; e4 += NGT) {
            if (e4 & 3) continue;
            const int idx = e4 >> 2;
            const int p = idx & 63, dir = (idx >> 6) & 1, g = (idx >> 7) & 127, layer = idx >> 14;
            const size_t pi = ((size_t)(layer * 2 + dir) * NG + g) * 64 + p;
            const double are = a_re[pi], aim = a_im[pi], dt = exp((double)log_dt[(layer * 2 + dir) * NG + g]);
            const double mag = exp(are * dt), ang = aim * dt;
            const double ar = mag * cos(ang), ai = mag * sin(ang);
            double zr = 1.0, zi = 0.0;
            for (int q = 0; q < 17; ++q) {
                s5t[((size_t)idx * 17 + q) * 2] = (float)zr; s5t[((size_t)idx * 17 + q) * 2 + 1] = (float)zi;
                const double tr = zr * ar - zi * ai, ti = zr * ai + zi * ar; zr = tr; zi = ti;
            }
            const double nr = ar - 1.0, ni = ai;
            const double den = are * are + aim * aim;
            const double fr_ = (nr * are + ni * aim) / den, fi_ = (ni * are - nr * aim) / den;
            for (int hq = 0; hq < 16; ++hq) {
                const double br = b_re[pi * 16 + hq], bim = b_im[pi * 16 + hq];
                s5t[S5T_BB_OFF + ((size_t)idx * 16 + hq) * 2] = (float)(fr_ * br - fi_ * bim); s5t[S5T_BB_OFF + ((size_t)idx * 16 + hq) * 2 + 1] = (float)(fr_ * bim + fi_ * br);
            }
        }
    }
}

__device__ __forceinline__ void phase_final(const Ctx& F, const bf16_t* hb, const float* ss, int nparts, const float* fn, float* out) {
    const int gw = F.c * 8 + F.wave, NGW = F.G * 8;
    for (int r = gw; r < NREAL; r += NGW) {
        const float inv = row_inv(ss, r, nparts);
        u32x4 hv[4];
#pragma unroll
        for (int j = 0; j < 4; ++j) hv[j] = *(const u32x4*)(hb + blk(r, 512 * j + 8 * F.lane, D / 64));
#pragma unroll
        for (int j = 0; j < 4; ++j) {
            const int c0 = 512 * j + 8 * F.lane;
            f32x4 v0, v1; unpack8(hv[j], v0, v1);
            const f32x4 g0 = *(const f32x4*)(fn + c0), g1 = *(const f32x4*)(fn + c0 + 4);
            *(f32x4*)(out + (size_t)r * D + c0) = v0 * inv * g0; *(f32x4*)(out + (size_t)r * D + c0 + 4) = v1 * inv * g1;
        }
    }
}

__device__ __forceinline__ void s5_build_group(const Ctx& F, int g, int half, const float* pwt, const float* bbt,
                                               const float* c_re, const float* c_im, const float* dvec, const float* gain, bf16_t* BmatT, bf16_t* WyT, float* A16) {
    LAS float* pw = (LAS float*)F.lds; LAS float* bb = pw + 4352; LAS float* cc = bb + 4096; LAS float* Kt = cc + 4096; LAS float* gn = Kt + 8192; LAS float* dd = gn + 16;
    const int tid = F.tid;
    __syncthreads();
    for (int e = tid; e < 2 * 64 * 17 * 2; e += 512) pw[e] = pwt[(size_t)g * (2 * 64 * 17 * 2) + e];
    for (int e = tid; e < 2 * 64 * 16 * 2; e += 512) bb[e] = bbt[(size_t)g * (2 * 64 * 16 * 2) + e];
    for (int e = tid; e < 2 * 16 * 64; e += 512) {
        const int dir = e >> 10, hh = (e >> 6) & 15, pp = e & 63;
        const size_t ci = ((size_t)((dir * NG + g) * 16 + hh)) * 64 + pp;
        cc[e * 2] = c_re[ci]; cc[e * 2 + 1] = c_im[ci];
    }
    if (tid < 16) { gn[tid] = gain[g * 16 + tid]; dd[tid] = dvec[g * 16 + tid]; }
    __syncthreads();
    {
        const int dir = tid >> 8, hh = (tid >> 4) & 15, hq = half * 8 + (tid & 7), tau0 = ((tid >> 3) & 1) * 8;
        float sacc[8];
#pragma unroll
        for (int k = 0; k < 8; ++k) sacc[k] = 0.f;
        for (int p = 0; p < 64; ++p) {
            const float cr = cc[((dir * 16 + hh) * 64 + p) * 2], ci = cc[((dir * 16 + hh) * 64 + p) * 2 + 1];
            const float br = bb[((dir * 64 + p) * 16 + hq) * 2], bi = bb[((dir * 64 + p) * 16 + hq) * 2 + 1];
            const float wr_ = cr * br - ci * bi, wi_ = cr * bi + ci * br;
#pragma unroll
            for (int k = 0; k < 8; ++k) { const float pr = pw[((dir * 64 + p) * 17 + tau0 + k) * 2], pi = pw[((dir * 64 + p) * 17 + tau0 + k) * 2 + 1]; sacc[k] += wr_ * pr - wi_ * pi; }
        }
#pragma unroll
        for (int k = 0; k < 8; ++k) Kt[(dir * 16 + tau0 + k) * 256 + hh * 16 + hq] = sacc[k];
    }
    __syncthreads();
    bf16_t* Bg = BmatT + (size_t)g * 256 * 256; bf16_t* Wg = WyT + (size_t)g * 256 * 512;
    for (int q2 = tid; q2 < 256 * 16; q2 += 512) { const int q = 2 * q2 + half;
        const int n = q >> 5, k0 = (q & 31) * 8, t = n >> 4, hh = n & 15, j = k0 >> 4, h0 = k0 & 15;
        float o[8];
#pragma unroll
        for (int e = 0; e < 8; ++e) {
            const int hq = h0 + e; float v = 0.f;
            if (j <= t) v += Kt[(0 * 16 + (t - j)) * 256 + hh * 16 + hq];
            if (j >= t) v += Kt[(1 * 16 + (j - t)) * 256 + hh * 16 + hq];
            if (j == t && hq == hh) v += dd[hh];
            o[e] = v * gn[hq];
        }
        u32x4 w; w.x = cvt_pk_bf16(o[0], o[1]); w.y = cvt_pk_bf16(o[2], o[3]); w.z = cvt_pk_bf16(o[4], o[5]); w.w = cvt_pk_bf16(o[6], o[7]);
        *(u32x4*)(Wg + blk(n, k0, 8)) = w;
    }
    for (int q2 = tid; q2 < 256 * 16; q2 += 512) { const int q = 2 * q2 + half;
        const int n = q >> 5, r0 = (q & 31) * 8, t = n >> 4, hh = n & 15, dir = r0 >> 7, part = (r0 >> 6) & 1, p0 = r0 & 63;
        const int ex = dir == 0 ? t + 1 : 16 - t;
        float o[8];
#pragma unroll
        for (int e = 0; e < 8; ++e) {
            const int p = p0 + e;
            const float cr = cc[((dir * 16 + hh) * 64 + p) * 2], ci = cc[((dir * 16 + hh) * 64 + p) * 2 + 1];
            const float pr = pw[((dir * 64 + p) * 17 + ex) * 2], pi = pw[((dir * 64 + p) * 17 + ex) * 2 + 1];
            o[e] = part == 0 ? (cr * pr - ci * pi) : -(cr * pi + ci * pr);
        }
        u32x4 w; w.x = cvt_pk_bf16(o[0], o[1]); w.y = cvt_pk_bf16(o[2], o[3]); w.z = cvt_pk_bf16(o[4], o[5]); w.w = cvt_pk_bf16(o[6], o[7]);
        *(u32x4*)(Wg + blk(n, 256 + r0, 8)) = w;
    }
    for (int q2 = tid; q2 < 256 * 16; q2 += 512) { const int q = 2 * q2 + half;
        const int col = q >> 5, k0 = (q & 31) * 8, dir = col >> 7, part = col & 1, p = (col >> 1) & 63, j = k0 >> 4, h0 = k0 & 15;
        const int ex = dir == 0 ? 15 - j : j;
        const float pr = pw[((dir * 64 + p) * 17 + ex) * 2], pi = pw[((dir * 64 + p) * 17 + ex) * 2 + 1];
        float o[8];
#pragma unroll
        for (int e = 0; e < 8; ++e) {
            const int hq = h0 + e;
            const float br = bb[((dir * 64 + p) * 16 + hq) * 2], bi = bb[((dir * 64 + p) * 16 + hq) * 2 + 1];
            o[e] = (part == 0 ? (pr * br - pi * bi) : (pr * bi + pi * br)) * gn[hq];
        }
        u32x4 w; w.x = cvt_pk_bf16(o[0], o[1]); w.y = cvt_pk_bf16(o[2], o[3]); w.z = cvt_pk_bf16(o[4], o[5]); w.w = cvt_pk_bf16(o[6], o[7]);
        *(u32x4*)(Bg + blk(col, k0, 4)) = w;
    }
    if (half == 0 && tid < 128) { const int dir = tid >> 6, p = tid & 63; A16[((g * 2 + dir) * 64 + p) * 2] = pw[((dir * 64 + p) * 17 + 16) * 2]; A16[((g * 2 + dir) * 64 + p) * 2 + 1] = pw[((dir * 64 + p) * 17 + 16) * 2 + 1]; }
    __syncthreads();
}

__device__ __forceinline__ void phase_s5a(const Ctx& F, const bf16_t* hb, const float* ss, int nparts, const float* sst, int ntp, bf16_t* XS) {
    LAS bf16_t* buf = (LAS bf16_t*)F.lds;
    u32x4 cv[2][4], nv[2][4]; float cinv[2], ninv[2];
#define S5A_LOAD(dv, dinv, cr_) do { _Pragma("unroll") for (int q = 0; q < 2; ++q) { const int t = F.wave * 2 + q, r = chunk_tok_row((cr_), t); \
        if (TAIL_DIRECT && r >= NREAL) { const float* p = sst + (r - NREAL) * 128; float v = F.lane < ntp ? p[F.lane] : 0.f; if (F.lane + 64 < ntp) v += p[64 + F.lane]; dinv[q] = rsqrtf(wave_sum(v) * (1.0f / D) + RMS_EPS); } \
        else dinv[q] = row_inv(ss, r, nparts); \
        _Pragma("unroll") for (int j = 0; j < 4; ++j) dv[q][j] = *(const u32x4*)(hb + blk(r, 512 * j + 8 * F.lane, D / 64)); } } while (0)
#define S5A_CHUNK(k_) (F.G != 256 ? F.c + (k_) * F.G : ((k_) < 8 ? 2 * (F.c + 256 * ((k_) >> 1)) + ((k_) & 1) : 2048 + F.c + ((k_) - 8) * 256))
    int kk = 0, cr = S5A_CHUNK(0);
    if (cr < NCH) S5A_LOAD(cv, cinv, cr);
    for (; cr < NCH; ) {
        const int crn = S5A_CHUNK(kk + 1); ++kk;
        __syncthreads();
#pragma unroll
        for (int q = 0; q < 2; ++q) {
            const int t = F.wave * 2 + q;
#pragma unroll
            for (int j = 0; j < 4; ++j) {
                f32x4 v0, v1; unpack8(cv[q][j], v0, v1);
                v0 *= cinv[q]; v1 *= cinv[q];
                u32x4 w; w.x = cvt_pk_bf16(v0[0], v0[1]); w.y = cvt_pk_bf16(v0[2], v0[3]); w.z = cvt_pk_bf16(v1[0], v1[1]); w.w = cvt_pk_bf16(v1[2], v1[3]);
                *(LAS u32x4*)(buf + t * 2048 + 512 * j + 8 * F.lane) = w;
            }
        }
        if (crn < NCH) S5A_LOAD(nv, ninv, crn);
        __syncthreads();
#pragma unroll
        for (int i = 0; i < 8; ++i) {
            const int q = F.tid + 512 * i, g = q >> 5, t = (q >> 1) & 15, half = q & 1;
            const u32x4 w = *(const LAS u32x4*)(buf + t * 2048 + g * 16 + half * 8);
            *(u32x4*)(XS + blk(g * NCHP + cr, t * 16 + half * 8, 8)) = w;
        }
#pragma unroll
        for (int q = 0; q < 2; ++q) { cinv[q] = ninv[q];
#pragma unroll
            for (int j = 0; j < 4; ++j) cv[q][j] = nv[q][j]; }
        cr = crn;
    }
#undef S5A_CHUNK
#undef S5A_LOAD
    __syncthreads();
}

__device__ __forceinline__ void phase_scan(const Ctx& F, const unsigned* Sloc, bf16_t* XS, const float* A16) {
    LAS float* carry = (LAS float*)F.lds;
    const int p = F.lane, w = F.wave;
#pragma unroll 1
    for (int task = F.c; task < 768; task += F.G) {
        const int so = task >> 8, g = F.G == 256 ? 16 * (F.c & 7) + (F.c >> 4) : (task >> 1) & 127, dir = F.G == 256 ? (F.c >> 3) & 1 : task & 1;
        const int s = so == 0 ? 2 : so - 1;
        const int crb = s == 2 ? 1026 : (s == 1 ? 513 : 0), n = s == 2 ? 1025 : 513, L = s == 2 ? 129 : 65, nsq = s == 2 ? 7 : 6;
        const int cb = w * L, ce = (cb + L) < n ? (cb + L) : n;
        const float ar = A16[((g * 2 + dir) * 64 + p) * 2], ai = A16[((g * 2 + dir) * 64 + p) * 2 + 1];
        const char* srcg = (const char*)(Sloc + (size_t)g * NCHP * 128);
        char* xsg = (char*)(XS + (size_t)g * ((NCHP / 256) * 8 * 16384));
        const unsigned lane_l = (unsigned)(dir * 64 + p) * 4u;
        const unsigned colre = 256u + (unsigned)dir * 128u + (unsigned)p;
        const unsigned lane_re = (((colre >> 6) << 14) + (((colre >> 5) & 1u) << 13) + (colre & 31u)) * 2u, lane_im = lane_re + 32768u;
        float sr = 0.f, si = 0.f;
        float lr[8], li[8], nr_[8], ni_[8];
#define SCAN_ROW(c_) ((unsigned)(crb + (dir ? n - 1 - (c_) : (c_))))
#define SCAN_LOAD(dr, di, c0_) do { _Pragma("unroll") for (int k = 0; k < 8; ++k) { int c = (c0_) + k; c = c < ce ? c : ce - 1; const unsigned w_ = *(const unsigned*)(srcg + (SCAN_ROW(c) * 512u + lane_l)); dr[k] = __builtin_bit_cast(float, w_ << 16); di[k] = __builtin_bit_cast(float, w_ & 0xffff0000u); } } while (0)
#define SCAN_ACC(dr, di, c0_) do { _Pragma("unroll") for (int k = 0; k < 8; ++k) { const int c = (c0_) + k; if (c < ce) { \
        const float tr = ar * sr - ai * si + dr[k], ti = ar * si + ai * sr + di[k]; sr = tr; si = ti; } } } while (0)
#define SCAN_STEP(dr, di, c0_) do { _Pragma("unroll") for (int k = 0; k < 8; ++k) { const int c = (c0_) + k; if (c < ce) { const unsigned rl_ = SCAN_ROW(c), ro_ = ((rl_ >> 8) << 18) + ((rl_ & 255u) << 6); \
        const unsigned pk = cvt_pk_bf16(sr, si); *(bf16_t*)(xsg + (ro_ + lane_re)) = (bf16_t)(pk & 0xffffu); *(bf16_t*)(xsg + (ro_ + lane_im)) = (bf16_t)(pk >> 16); \
        const float tr = ar * sr - ai * si + dr[k], ti = ar * si + ai * sr + di[k]; sr = tr; si = ti; } } } while (0)
        SCAN_LOAD(lr, li, cb);
#pragma unroll 1
        for (int c0 = cb; c0 < ce; c0 += 16) {
            SCAN_LOAD(nr_, ni_, c0 + 8);
            SCAN_ACC(lr, li, c0);
            SCAN_LOAD(lr, li, c0 + 16);
            SCAN_ACC(nr_, ni_, c0 + 8);
        }
        carry[(w * 64 + p) * 2] = sr; carry[(w * 64 + p) * 2 + 1] = si;
        float qr = ar, qi = ai;
#pragma unroll 1
        for (int k = 0; k < nsq; ++k) { const float tr = qr * qr - qi * qi, ti = 2.0f * qr * qi; qr = tr; qi = ti; }
        { const float tr = qr * ar - qi * ai, ti = qr * ai + qi * ar; qr = tr; qi = ti; }
        SCAN_LOAD(lr, li, cb);
        __syncthreads();
        sr = 0.f; si = 0.f;
#pragma unroll 1
        for (int j = 0; j < w; ++j) { const float pr = carry[(j * 64 + p) * 2], pi = carry[(j * 64 + p) * 2 + 1]; const float tr = qr * sr - qi * si + pr, ti = qr * si + qi * sr + pi; sr = tr; si = ti; }
#pragma unroll 1
        for (int c0 = cb; c0 < ce; c0 += 16) {
            SCAN_LOAD(nr_, ni_, c0 + 8);
            SCAN_STEP(lr, li, c0);
            SCAN_LOAD(lr, li, c0 + 16);
            SCAN_STEP(nr_, ni_, c0 + 8);
        }
        __syncthreads();
#undef SCAN_ROW
#undef SCAN_LOAD
#undef SCAN_ACC
#undef SCAN_STEP
    }
}

__device__ __forceinline__ void phase_attn(const Ctx& F, const bf16_t* QK, const bf16_t* Vt, bf16_t* O, const float* sink) {
    const int lane = F.lane, r = lane & 31, hh = lane >> 5, wave = F.wave, tid = F.tid;
    constexpr int KROW = 272, VROW = 72, KBYTES = 32 * KROW, STAGE = KBYTES + 128 * VROW;
    const int lk_key = tid >> 4, lk_ch = tid & 15, lv_d = tid >> 2, lv_kc = tid & 3;
    for (int unit = F.c; unit < 2048 + 12; unit += F.G) {
        int s, kh, qrow, head, pq, ktlo, kthi, wlo, whi; bool active = true;
        if (unit < 2048) {
            int um = unit;
            if (F.G == 256) { const int li = (unit >> 8) * 32 + (F.c >> 3); um = (((F.c & 7) * 64 + (li >> 2)) << 2) | (li & 3); }
            const int qb = um >> 2; kh = um & 3; head = kh * 4 + (wave >> 1);
            const int q0 = qb * 64; s = q0 >= 16384 ? 2 : (q0 >= 8192 ? 1 : 0);
            const int rb = s == 2 ? 16384 : s * 8192, S = s == 2 ? 16384 : 8192, q0rel = q0 - rb, qrel = q0rel + (wave & 1) * 32;
            qrow = q0 + (wave & 1) * 32 + r; pq = qrel + r + 16;
            int lo = q0rel - 128; lo = lo < 0 ? 0 : lo; int hi = q0rel + 192; hi = hi > S ? S : hi; ktlo = lo >> 5; kthi = hi >> 5;
            lo = qrel - 128; lo = lo < 0 ? 0 : lo; hi = qrel + 160; hi = hi > S ? S : hi; wlo = lo >> 5; whi = hi >> 5;
        } else {
            const int mu = unit - 2048; s = mu >> 2; kh = mu & 3; active = wave < 2;
            head = kh * 4 + (wave & 1) * 2 + (r >> 4); qrow = NREAL + 16 * s + (r & 15); pq = r & 15; ktlo = 0; kthi = 4; wlo = 0; whi = 4;
        }
        const int rb = s == 2 ? 16384 : s * 8192, ntiles = 1 + kthi - ktlo;
        bf16x8 qf[8];
#pragma unroll
        for (int ks = 0; ks < 8; ++ks) qf[ks] = *(const bf16x8*)(QK + (size_t)qrow * QKLD + head * 128 + 16 * ks + 8 * hh);
        f32x16 o[4];
#pragma unroll
        for (int db = 0; db < 4; ++db)
#pragma unroll
            for (int e = 0; e < 16; ++e) o[db][e] = 0.f;
        float mrun = sink[head] * LOG2E, lrun = 1.0f;
        u32x4 kreg, vreg;
        { const int krow0 = NREAL + 16 * s;
          kreg = *(const u32x4*)(QK + (size_t)(krow0 + (lk_key & 15)) * QKLD + 2048 + kh * 128 + lk_ch * 8);
          vreg = *(const u32x4*)(Vt + (size_t)(kh * 128 + lv_d) * MPAD + krow0 + lv_kc * 8); }
        const int qrel_s = unit < 2048 ? __builtin_amdgcn_readfirstlane(pq - r - 16) : (1 << 28);
        for (int t = 0; t < ntiles; ++t) {
            LAS unsigned char* st = F.lds + (t & 1) * STAGE;
            *(LAS u32x4*)(st + lk_key * KROW + lk_ch * 16) = kreg;
            { LAS unsigned char* vp = st + KBYTES + lv_d * VROW + lv_kc * 16; *(LAS u32x2*)(vp) = (u32x2){vreg.x, vreg.y}; *(LAS u32x2*)(vp + 8) = (u32x2){vreg.z, vreg.w}; }
            if (t + 1 < ntiles) { const int krow0 = rb + (ktlo + t) * 32;
                kreg = *(const u32x4*)(QK + (size_t)(krow0 + lk_key) * QKLD + 2048 + kh * 128 + lk_ch * 8);
                vreg = *(const u32x4*)(Vt + (size_t)(kh * 128 + lv_d) * MPAD + krow0 + lv_kc * 8); }
            asm volatile("s_waitcnt lgkmcnt(0)" ::: "memory"); __builtin_amdgcn_s_barrier(); asm volatile("" ::: "memory");
            const bool ismeta = t == 0; const int kt = ktlo + t - 1;
            if (active && (ismeta || (kt >= wlo && kt < whi))) {
                f32x16 sc, sc2;
#pragma unroll
                for (int e = 0; e < 16; ++e) { sc[e] = 0.f; sc2[e] = 0.f; }
#pragma unroll
                for (int ks = 0; ks < 8; ks += 2) {
                    const bf16x8 kf = *(const LAS bf16x8*)(st + r * KROW + 32 * ks + 16 * hh), kg = *(const LAS bf16x8*)(st + r * KROW + 32 * (ks + 1) + 16 * hh);
                    sc = __builtin_amdgcn_mfma_f32_32x32x16_bf16(kf, qf[ks], sc, 0, 0, 0);
                    sc2 = __builtin_amdgcn_mfma_f32_32x32x16_bf16(kg, qf[ks + 1], sc2, 0, 0, 0);
                }
#pragma unroll
                for (int e = 0; e < 16; ++e) sc[e] += sc2[e];
                float mx = -INFINITY;
                const int d0_ = qrel_s - kt * 32;
                if (!ismeta && d0_ >= -97 && d0_ <= 97) {
#pragma unroll
                    for (int e = 0; e < 16; ++e) mx = fmaxf(mx, sc[e]);
                } else {
#pragma unroll
                for (int e = 0; e < 16; ++e) {
                    const int kl = (e & 3) + 8 * (e >> 2) + 4 * hh;
                    bool ok;
                    if (ismeta) ok = kl < 16; else { const int dlt = pq - (kt * 32 + kl + 16); ok = (dlt <= 128) && (dlt >= -128); }
                    sc[e] = ok ? sc[e] : -INFINITY; mx = fmaxf(mx, sc[e]);
                }
                }
                mx = fmaxf(mx, __shfl_xor(mx, 32));
                const float mnew = fmaxf(mrun, mx), alpha = fast_exp2(mrun - mnew);
                float psum = 0.f;
#pragma unroll
                for (int e = 0; e < 16; ++e) { sc[e] = fast_exp2(sc[e] - mnew); psum += sc[e]; }
                psum += __shfl_xor(psum, 32);
                lrun = lrun * alpha + psum; mrun = mnew;
                if (!__all(alpha == 1.0f)) {
#pragma unroll
                    for (int db = 0; db < 4; ++db)
#pragma unroll
                        for (int e = 0; e < 16; ++e) o[db][e] *= alpha;
                }
                bf16x8 pf[2];
#pragma unroll
                for (int sx = 0; sx < 2; ++sx) {
                    u32x4 w; w.x = cvt_pk_bf16(sc[8 * sx + 0], sc[8 * sx + 1]); w.y = cvt_pk_bf16(sc[8 * sx + 2], sc[8 * sx + 3]); w.z = cvt_pk_bf16(sc[8 * sx + 4], sc[8 * sx + 5]); w.w = cvt_pk_bf16(sc[8 * sx + 6], sc[8 * sx + 7]);
                    pf[sx] = __builtin_bit_cast(bf16x8, w);
                }
#pragma unroll
                for (int sx = 0; sx < 2; ++sx) {
                    if (ismeta && sx == 1) continue;
#pragma unroll
                    for (int db = 0; db < 4; ++db) {
                        const LAS unsigned char* vp = st + KBYTES + (32 * db + r) * VROW + 32 * sx + 8 * hh;
                        const u32x2 lo2 = *(const LAS u32x2*)(vp), hi2 = *(const LAS u32x2*)(vp + 16);
                        u32x4 w; w.x = lo2.x; w.y = lo2.y; w.z = hi2.x; w.w = hi2.y;
                        o[db] = __builtin_amdgcn_mfma_f32_32x32x16_bf16(__builtin_bit_cast(bf16x8, w), pf[sx], o[db], 0, 0, 0);
                    }
                }
            }
        }
        if (active) {
            const float il = 1.0f / lrun;
#pragma unroll
            for (int db = 0; db < 4; ++db)
#pragma unroll
                for (int eq = 0; eq < 4; ++eq) {
                    u32x2 w; w.x = cvt_pk_bf16(o[db][4 * eq + 0] * il, o[db][4 * eq + 1] * il); w.y = cvt_pk_bf16(o[db][4 * eq + 2] * il, o[db][4 * eq + 3] * il);
                    *(u32x2*)(O + blk(qrow, head * 128 + 32 * db + 8 * eq + 4 * hh, D / 64)) = w;
                }
        }
        asm volatile("s_waitcnt lgkmcnt(0)" ::: "memory"); __builtin_amdgcn_s_barrier(); asm volatile("" ::: "memory");
    }
}

__device__ __forceinline__ void zero_pad_rows(const Ctx& F, bf16_t* buf) {
    const int gt = F.c * 512 + F.tid, NGT = F.G * 512;
    unsigned z = 0u; asm volatile("" : "+v"(z));
    constexpr int PER_KH = (MPAD - MVALID) * 32 / 8;
    for (int e = gt; e < PER_KH * 2 * (D / 64); e += NGT) { const int kh2 = e / PER_KH, q = e - kh2 * PER_KH;
        *(u32x4*)(buf + ((size_t)((MVALID >> 8) * (D / 64)) << 14) + (size_t)kh2 * 8192 + (size_t)(MVALID & 255) * 32 + (size_t)q * 8) = (u32x4){z, z, z, z}; }
}

template <class KA>
__device__ __forceinline__ void prep_layer(const Ctx& Fp, KA ka, int layer, int s0, int s1, int NS, int wave_lo) {
    unsigned char* wb = ka->ws + ((layer & 1) ? WS_W1 : WS_W);
    const int jm = layer >> 1; const bool is_s5 = (layer & 1) == 0;
    if (is_s5) {
        for (int it = 2 * NG * s0 / NS + Fp.c; it < 2 * NG * s1 / NS; it += Fp.G)
            s5_build_group(Fp, it % NG, it / NG, (const float*)(ka->ws + WS_S5T) + (size_t)jm * S5T_PW_L, (const float*)(ka->ws + WS_S5T) + S5T_BB_OFF + (size_t)jm * S5T_BB_L,
                           ka->in[13] + (size_t)jm * 2 * NG * 16 * 64, ka->in[14] + (size_t)jm * 2 * NG * 16 * 64,
                           ka->in[15] + (size_t)jm * D, ka->in[3] + (size_t)(layer * 3 + 1) * D, (bf16_t*)(wb + OW_WMIX + MIX_BMAT), (bf16_t*)(wb + OW_WMIX + MIX_WY), (float*)(ka->ws + WS_A16));
        __syncthreads();
    }
    for (int mi = 0; mi < 8; ++mi) {
        const float* W; int K, N, kind; const float* gain = nullptr; bf16_t* WT; bf16_t* WT2 = nullptr;
        if (mi < 2) {
            if (is_s5) { W = ka->in[16] + (size_t)(jm * 2 + mi) * D * D; K = D; N = D; WT = (bf16_t*)(wb + OW_WMIX + MIX_WGLU); kind = 1 + mi; }
            else if (mi == 0) { W = ka->in[17] + (size_t)jm * D * 3072; K = D; N = 3072; gain = ka->in[3] + (size_t)(layer * 3 + 1) * D; WT = (bf16_t*)(wb + OW_WMIX + MIX_WQK); WT2 = (bf16_t*)(wb + OW_WMIX + MIX_WVT); kind = 3; }
            else { W = ka->in[18] + (size_t)jm * D * D; K = D; N = D; WT = (bf16_t*)(wb + OW_WMIX + MIX_WO); kind = 0; }
        } else {
            const int hf = (mi - 2) / 3, wm = (mi - 2) - 3 * hf; const size_t wi = (size_t)(layer * 2 + hf);
            if (wm < 2) { W = ka->in[5 + wm] + wi * D * DFF; K = D; N = DFF; gain = ka->in[3] + (size_t)(layer * 3 + 2 * hf) * D; WT = (bf16_t*)(wb + (hf ? OW_WGU_B : OW_WGU_A)); kind = 1 + wm; }
            else { W = ka->in[7] + wi * DFF * D; K = DFF; N = D; WT = (bf16_t*)(wb + (hf ? OW_WD_B : OW_WD_A)); kind = 0; }
        }
        transpose_matrix(Fp, W, K, N, gain, WT, WT2, kind, s0, s1, NS, wave_lo);
    }
}

struct Args { const float* in[20]; float* out; unsigned char* ws; int ph_lo, ph_hi, li, pad; };
constexpr int PH_FINAL = 41, PH_END = 42;

typedef const __attribute__((address_space(4))) Args* KArgs;
__device__ __forceinline__ KArgs kargs() { KArgs p = (KArgs)__builtin_amdgcn_kernarg_segment_ptr(); asm volatile("" : "+s"(p)); return p; }

__global__ void __launch_bounds__(512, 2) fwd_kernel(Args args) {
    extern __shared__ __attribute__((aligned(16))) unsigned char lds_raw[];
    Ctx F; F.lds = (LAS unsigned char*)lds_raw; F.tid = threadIdx.x; F.lane = F.tid & 63; F.wave = __builtin_amdgcn_readfirstlane(F.tid >> 6); F.G = gridDim.x; F.c = blockIdx.x;
    volatile LAS unsigned* MISC = (volatile LAS unsigned*)(F.lds + MISC_OFF);
    if (F.tid < 64) MISC[F.tid] = 0u;
    __syncthreads();
    XcdBarrier bar = xcd_barrier_post((unsigned*)(args.ws + WS_CTL) + 4096 + args.li * XCD_BAR_WORDS, MISC + 8);
    const int lo = args.ph_lo, hi = args.ph_hi;
#if TIMING
    if (F.c == 0 && threadIdx.x == 0) { volatile LAS unsigned* T_ = (volatile LAS unsigned*)(F.lds + MISC_OFF + 256); const unsigned long long t_ = __builtin_amdgcn_s_memrealtime(); T_[0] = (unsigned)t_; T_[1] = (unsigned)(t_ >> 32); for (int k = 0; k < 16; ++k) T_[2 + k] = 0u; }
#endif
#ifndef PHMASK
#define PHMASK 0xFFFF
#endif
#define IN(k) (lo <= (k) && (k) < hi)
#define EN(b) ((PHMASK >> (b)) & 1)
#if TIMING
#define SEAM(k) do { if ((k) + 1 < hi) xcd_barrier(bar); } while (0)
#define TSTAMP(kind) do { if (F.c == 0 && threadIdx.x == 0) { const unsigned long long t_ = __builtin_amdgcn_s_memrealtime(); volatile LAS unsigned* T_ = (volatile LAS unsigned*)(F.lds + MISC_OFF + 256); \
        const unsigned long long p_ = ((unsigned long long)T_[1] << 32) | T_[0]; T_[2 + (kind)] += (unsigned)(t_ - p_); T_[0] = (unsigned)t_; T_[1] = (unsigned)(t_ >> 32); } } while (0)
#else
#define SEAM(k) do { if ((k) + 1 < hi || PROBE_DOUBLE) xcd_barrier(bar); } while (0)
#define TSTAMP(kind) do { } while (0)
#endif
#define WSP(T, off) ((T*)(ws + (off)))
#define PREP_GAP(nbusy, s0, s1) do { if (PREP_MODE == 1 && EN(1) && layer < 3 && F.c >= (nbusy)) { Ctx Fp = fresh(F); Fp.c = F.c - (nbusy); Fp.G = F.G - (nbusy); \
        prep_layer(Fp, kargs(), layer + 1, (s0), (s1), is_s5 ? 16 : 13, 0); __syncthreads(); } } while (0)

    if (EN(0) && IN(0)) for (int rep = 0; rep < NREP(0); ++rep) { KArgs ka = kargs(); unsigned char* ws = ka->ws;
        phase_init(fresh(F), ka->in[0], ka->in[1], ka->in[2], WSP(bf16_t, WS_HB), WSP(float, WS_SS), WSP(float, WS_SST), WSP(float, WS_ROPE), WSP(float, WS_ROPE + ROPE_HALF),
                   ka->in[8], ka->in[9], ka->in[10], ka->in[11], ka->in[12], WSP(float, WS_S5T));
        if (EN(1)) { xcd_barrier(bar); prep_layer(fresh(F), kargs(), 0, 0, 1, 1, 0); __syncthreads(); }
        SEAM(0); TSTAMP(0); }

    int nparts = 8;
    int ntp = 1;
    for (int sb = 0; sb < 12; ++sb) {
        const int layer = sb / 3, kind = sb - 3 * layer, pbase = 1 + 10 * layer, jm = layer >> 1;
        const bool is_s5 = (layer & 1) == 0;
        if (PREP_MODE == 0 && kind == 0 && layer > 0 && EN(1) && IN(pbase)) { prep_layer(fresh(F), kargs(), layer, 0, 1, 1, 0); __syncthreads(); SEAM(pbase); TSTAMP(1); }
        if (kind != 1) {
            const int p1 = pbase + (kind == 0 ? 1 : 8), p2 = p1 + 1;
            if (EN(2) && IN(p1)) for (int rep = 0; rep < NREP(2); ++rep) {
                KArgs ka = kargs(); unsigned char* ws = ka->ws;
                pg8::Gemm g{WSP(bf16_t, WS_HB), (bf16_t*)(ws + ((layer & 1) ? WS_W1 : WS_W) + (kind == 0 ? OW_WGU_A : OW_WGU_B)), D / 64, D / 64, D}; pg8::StaticOrder S; S.init(NREAL, 2 * DFF, F.G, F.c);
                EpiSwiGLU E{WSP(bf16_t, WS_ACT), WSP(float, WS_SS), (PROBE_EMPTY_EPI && rep + 1 < NREP(2)) ? -1 : nparts, F.lds};
                if (PROBE_EMPTY_EPI == 2 && rep + 1 < NREP(2)) pg8::gemm_phase<EpiSwiGLU, pg8::StaticOrder, 3>(F.lds, g, S, E); else
                pg8::gemm_phase<EpiSwiGLU, pg8::StaticOrder>(F.lds, g, S, E);

#if TAIL_DIRECT
                if (F.c * 2 < 352) { const Ctx Ft = fresh(F); tail_inv48(Ft, WSP(float, WS_SST), ntp);
                    TEpiSwiGLU TE{WSP(bf16_t, WS_ACT), (const LAS float*)(F.lds + TAIL_LDS_INV)};
                    tail_gemm<4>(Ft, g.A, D / 64, g.Bt, D / 64, D, 352, TMapPair(), TE); }
#else
                { pg8::SplitTailOrder T; T.init((2 * DFF) / 256, 4, 8, NREAL / 256, 1, F.c); pg8::Gemm g2 = g; g2.K = 512;
                  EpiSplit<EpiSwiGLU, 1> ES{E, WSP(float, WS_PART), (unsigned*)(ws + WS_CTL) + CW_TICK + (p1) * 1024, 4, MISC + 16};
                  pg8::gemm_phase<EpiSplit<EpiSwiGLU, 1>, pg8::SplitTailOrder, 1>(F.lds, g2, T, ES); }
#endif
                                if (rep + 1 == NREP(2)) { const int q0 = is_s5 ? (kind == 0 ? 0 : 13) : (kind == 0 ? 0 : 10); PREP_GAP(176, q0, q0 + 1); }
                SEAM(p1); TSTAMP(2);
            }
            if (EN(3) && IN(p2)) for (int rep = 0; rep < NREP(3); ++rep) {
                KArgs ka = kargs(); unsigned char* ws = ka->ws;
                pg8::Gemm g{WSP(bf16_t, WS_ACT), (bf16_t*)(ws + ((layer & 1) ? WS_W1 : WS_W) + (kind == 0 ? OW_WD_A : OW_WD_B)), DFF / 64, DFF / 64, DFF}; pg8::StaticOrder S; S.init(NREAL, D, F.G, F.c, 4);
                EpiResid E{WSP(bf16_t, WS_HB), WSP(float, WS_SS), (rep + 1 < NREP(3)) ? 0.0f : 0.5f, (LAS float*)(F.lds + RED_OFF)};
                pg8::gemm_phase<EpiResid, pg8::StaticOrder>(F.lds, g, S, E);

#if TAIL_DIRECT
                if (F.c < 64) { const Ctx Ft = fresh(F);
                    TEpiResid TE{WSP(bf16_t, WS_HB), WSP(float, WS_SST), E.scale};
                    tail_gemm<8>(Ft, g.A, DFF / 64, g.Bt, DFF / 64, DFF, 64, TMapPlain(), TE); }
#else
                { pg8::SplitTailOrder T; T.init(D / 256, 11, 8, NREAL / 256, 1, F.c); pg8::Gemm g2 = g; g2.K = 512;
                  EpiSplit<EpiResid, 1> ES{E, WSP(float, WS_PART), (unsigned*)(ws + WS_CTL) + CW_TICK + (p2) * 1024, 11, MISC + 16};
                  pg8::gemm_phase<EpiSplit<EpiResid, 1>, pg8::SplitTailOrder, 1>(F.lds, g2, T, ES); }
#endif
                                if (rep + 1 == NREP(3)) { const int q0 = is_s5 ? (kind == 0 ? 1 : 14) : (kind == 0 ? 1 : 11); PREP_GAP(88, q0, q0 + 2); }
                if (PREP_MODE == 2 && EN(1) && kind == 2 && layer < 3 && rep + 1 == NREP(3)) { prep_layer(fresh(F), kargs(), layer + 1, 0, 1, 1, 0); __syncthreads(); }
                SEAM(p2); TSTAMP(3);
            }
            nparts = 8; ntp = 64;
        } else if (is_s5) {
            if (EN(4) && IN(pbase + 3)) for (int rep = 0; rep < NREP(4); ++rep) { KArgs ka = kargs(); unsigned char* ws = ka->ws; phase_s5a(fresh(F), WSP(bf16_t, WS_HB), WSP(float, WS_SS), nparts, WSP(float, WS_SST), ntp, WSP(bf16_t, WS_ACT)); SEAM(pbase + 3); TSTAMP(4); }
            if (EN(5) && IN(pbase + 4)) for (int rep = 0; rep < NREP(5); ++rep) {
                KArgs ka = kargs(); unsigned char* ws = ka->ws;
                pg8::Gemm g{WSP(bf16_t, WS_ACT), (bf16_t*)(ws + ((layer & 1) ? WS_W1 : WS_W) + OW_WMIX + MIX_BMAT), 8, 4, 256}; pg8::BlockDiagOrder S; S.init(F.G, F.c);
                EpiSloc E{WSP(bf16_t, WS_R2)};
                pg8::gemm_phase<EpiSloc, pg8::BlockDiagOrder>(F.lds, g, S, E);
                SEAM(pbase + 4); TSTAMP(5);
            }
            if (EN(6) && IN(pbase + 5)) for (int rep = 0; rep < NREP(6); ++rep) { KArgs ka = kargs(); unsigned char* ws = ka->ws; phase_scan(fresh(F), WSP(unsigned, WS_R2), WSP(bf16_t, WS_ACT), WSP(float, WS_A16));
                if (PREP_MODE == 1 && EN(1) && layer < 3 && rep + 1 == NREP(6)) prep_layer(fresh(F), kargs(), layer + 1, 3, 11, 16, 3);
                SEAM(pbase + 5); TSTAMP(6); }
            if (EN(7) && IN(pbase + 6)) for (int rep = 0; rep < NREP(7); ++rep) {
                KArgs ka = kargs(); unsigned char* ws = ka->ws;
                pg8::Gemm g{WSP(bf16_t, WS_ACT), (bf16_t*)(ws + ((layer & 1) ? WS_W1 : WS_W) + OW_WMIX + MIX_WY), 8, 8, 512}; pg8::BlockDiagOrder S; S.init(F.G, F.c);
                EpiY E{WSP(bf16_t, WS_R2)};
                pg8::gemm_phase<EpiY, pg8::BlockDiagOrder>(F.lds, g, S, E);
                zero_pad_rows(fresh(F), WSP(bf16_t, WS_R2));
                SEAM(pbase + 6); TSTAMP(7);
            }
            if (EN(8) && IN(pbase + 7)) for (int rep = 0; rep < NREP(8); ++rep) {
                KArgs ka = kargs(); unsigned char* ws = ka->ws;
                pg8::Gemm g{WSP(bf16_t, WS_R2), (bf16_t*)(ws + ((layer & 1) ? WS_W1 : WS_W) + OW_WMIX + MIX_WGLU), D / 64, D / 64, D}; pg8::StaticOrder S; S.init(NREAL, 2 * D, F.G, F.c);
                EpiGLU E{WSP(bf16_t, WS_HB), WSP(float, WS_SS), (rep + 1 < NREP(8)) ? 0.0f : 1.0f, (LAS float*)(F.lds + RED_OFF)};
                pg8::gemm_phase<EpiGLU, pg8::StaticOrder>(F.lds, g, S, E);

#if TAIL_DIRECT
                if (F.c * 2 < 128) { const Ctx Ft = fresh(F);
                    TEpiGLU TE{WSP(bf16_t, WS_HB), WSP(float, WS_SST), E.scale};
                    tail_gemm<4>(Ft, g.A, D / 64, g.Bt, D / 64, D, 128, TMapPair(), TE); }
#else
                { pg8::SplitTailOrder T; T.init((2 * D) / 256, 4, 8, NREAL / 256, 1, F.c); pg8::Gemm g2 = g; g2.K = 512;
                  EpiSplit<EpiGLU, 1> ES{E, WSP(float, WS_PART), (unsigned*)(ws + WS_CTL) + CW_TICK + (pbase + 7) * 1024, 4, MISC + 16};
                  pg8::gemm_phase<EpiSplit<EpiGLU, 1>, pg8::SplitTailOrder, 1>(F.lds, g2, T, ES); }
#endif
                                if (rep + 1 == NREP(8)) PREP_GAP(64, 11, 13);
                SEAM(pbase + 7); TSTAMP(8);
            }
            nparts = 16; ntp = 128;
        } else {
            if (EN(9) && IN(pbase + 3)) for (int rep = 0; rep < NREP(9); ++rep) {
                { KArgs ka = kargs(); unsigned char* ws = ka->ws;
                  pg8::Gemm g{WSP(bf16_t, WS_HB), (bf16_t*)(ws + ((layer & 1) ? WS_W1 : WS_W) + OW_WMIX + MIX_WQK), D / 64, D / 64, D}; pg8::StaticOrder S; S.init(NREAL, QKLD, F.G, F.c);
                  EpiQK E{WSP(bf16_t, WS_ACT), WSP(float, WS_SS), nparts, WSP(float, WS_ROPE), WSP(float, WS_ROPE + ROPE_HALF), 0.08838834764831845f * LOG2E};
                  pg8::gemm_phase<EpiQK, pg8::StaticOrder>(F.lds, g, S, E);

#if TAIL_DIRECT
                  if (F.c * 2 < 80) { const Ctx Ft = fresh(F); tail_inv48(Ft, WSP(float, WS_SST), ntp);
                    TEpiQK TE{WSP(bf16_t, WS_ACT), (const LAS float*)(F.lds + TAIL_LDS_INV), WSP(float, WS_ROPE), WSP(float, WS_ROPE + ROPE_HALF), 0.08838834764831845f * LOG2E};
                    tail_gemm<4>(Ft, g.A, D / 64, g.Bt, D / 64, D, 80, TMapQK(), TE); }
#else
                { pg8::SplitTailOrder T; T.init(QKLD / 256, 4, 8, NREAL / 256, 1, F.c); pg8::Gemm g2 = g; g2.K = 512;
                  EpiSplit<EpiQK, 1> ES{E, WSP(float, WS_PART), (unsigned*)(ws + WS_CTL) + CW_TICK + (pbase + 3) * 1024, 4, MISC + 16};
                  pg8::gemm_phase<EpiSplit<EpiQK, 1>, pg8::SplitTailOrder, 1>(F.lds, g2, T, ES); }
#endif
                 }
                if (rep + 1 == NREP(9)) PREP_GAP(40, 3, 5);
                { KArgs ka = kargs(); unsigned char* ws = ka->ws;
                  pg8::Gemm g{(bf16_t*)(ws + ((layer & 1) ? WS_W1 : WS_W) + OW_WMIX + MIX_WVT), WSP(bf16_t, WS_HB), D / 64, D / 64, D}; pg8::StaticOrder S; S.init(512, NREAL, F.G, F.c);
                  EpiVt E{WSP(bf16_t, WS_VT), WSP(float, WS_SS), nparts};
                  pg8::gemm_phase<EpiVt, pg8::StaticOrder>(F.lds, g, S, E);

#if TAIL_DIRECT
                  if (F.c * 2 < 16) { const Ctx Ft = fresh(F); tail_inv48(Ft, WSP(float, WS_SST), ntp);
                    TEpiVt TE{WSP(bf16_t, WS_VT), (const LAS float*)(F.lds + TAIL_LDS_INV)};
                    tail_gemm<4>(Ft, g.Bt, D / 64, g.A, D / 64, D, 16, TMapPlain(), TE); }
#else
                { pg8::SplitTailOrder T; T.init(2, 4, 8, NREAL / 256, 2, F.c); pg8::Gemm g2 = g; g2.K = 512;
                  EpiSplit<EpiVt, 2> ES{E, WSP(float, WS_PART), (unsigned*)(ws + WS_CTL) + CW_TICK + (pbase + 6) * 1024, 4, MISC + 16};
                  pg8::gemm_phase<EpiSplit<EpiVt, 2>, pg8::SplitTailOrder, 2>(F.lds, g2, T, ES); }
#endif
                 }
                if (rep + 1 == NREP(9)) PREP_GAP(8, 5, 8);
                SEAM(pbase + 3); TSTAMP(9);
            }
            if (EN(10) && IN(pbase + 4)) for (int rep = 0; rep < NREP(10); ++rep) { KArgs ka = kargs(); unsigned char* ws = ka->ws;
                phase_attn(fresh(F), WSP(bf16_t, WS_ACT), WSP(bf16_t, WS_VT), WSP(bf16_t, WS_R2), ka->in[19] + jm * 16); zero_pad_rows(fresh(F), WSP(bf16_t, WS_R2)); SEAM(pbase + 4); TSTAMP(10); }
            if (EN(11) && IN(pbase + 5)) for (int rep = 0; rep < NREP(11); ++rep) {
                KArgs ka = kargs(); unsigned char* ws = ka->ws;
                pg8::Gemm g{WSP(bf16_t, WS_R2), (bf16_t*)(ws + ((layer & 1) ? WS_W1 : WS_W) + OW_WMIX + MIX_WO), D / 64, D / 64, D}; pg8::StaticOrder S; S.init(NREAL, D, F.G, F.c);
                EpiResid E{WSP(bf16_t, WS_HB), WSP(float, WS_SS), (rep + 1 < NREP(11)) ? 0.0f : 1.0f, (LAS float*)(F.lds + RED_OFF)};
                pg8::gemm_phase<EpiResid, pg8::StaticOrder>(F.lds, g, S, E);

#if TAIL_DIRECT
                if (F.c * 2 < 64) { const Ctx Ft = fresh(F);
                    TEpiResid TE{WSP(bf16_t, WS_HB), WSP(float, WS_SST), E.scale};
                    tail_gemm<4>(Ft, g.A, D / 64, g.Bt, D / 64, D, 64, TMapPlain(), TE); }
#else
                { pg8::SplitTailOrder T; T.init(D / 256, 4, 8, NREAL / 256, 1, F.c); pg8::Gemm g2 = g; g2.K = 512;
                  EpiSplit<EpiResid, 1> ES{E, WSP(float, WS_PART), (unsigned*)(ws + WS_CTL) + CW_TICK + (pbase + 5) * 1024, 4, MISC + 16};
                  pg8::gemm_phase<EpiSplit<EpiResid, 1>, pg8::SplitTailOrder, 1>(F.lds, g2, T, ES); }
#endif
                                if (rep + 1 == NREP(11)) PREP_GAP(32, 8, 10);
                SEAM(pbase + 5); TSTAMP(11);
            }
            nparts = 8; ntp = 64;
        }
    }
#if TIMING
    {
        KArgs ka = kargs(); unsigned char* ws = ka->ws; float* tv = WSP(float, WS_CTL + 900 * 1024);
        if (F.c == 0 && threadIdx.x == 0) { volatile LAS unsigned* T_ = (volatile LAS unsigned*)(F.lds + MISC_OFF + 256); float a = 0.f, b = 0.f;
            for (int k = 0; k < 16; ++k) { const float us = (float)T_[2 + k] * 0.01f; if ((TIMING_A >> k) & 1) a += us; if ((TIMING_B >> k) & 1) b += us; }
            tv[0] = a; tv[1] = b * TIMING_BSCALE; }
        xcd_barrier(bar);
        const float a = tv[0], b = tv[1]; float* out = ka->out;
        for (size_t e = (size_t)F.c * 512 + threadIdx.x; e < (size_t)NREAL * D; e += (size_t)F.G * 512) out[e] = (e == 0) ? b : a;
    }
#else
    if (EN(12) && IN(PH_FINAL)) for (int rep = 0; rep < NREP(12); ++rep) { KArgs ka = kargs(); unsigned char* ws = ka->ws; phase_final(fresh(F), WSP(bf16_t, WS_HB), WSP(float, WS_SS), nparts, ka->in[4], ka->out); }
#endif
#undef IN
#undef SEAM
#undef EN
#undef WSP
}

#ifndef N_LAUNCH_MODE
#define N_LAUNCH_MODE 0
#endif
extern "C" void kernel_launch(void* const* d_in, const int* in_sizes, int n_in, void* d_out, int out_size, void* d_ws, size_t ws_size, hipStream_t stream) {
    static int grid = 0;
    if (grid == 0) {
        if (n_in != 20 || ws_size < WS_END) { fprintf(stderr, "kernel_launch: need 20 inputs and %zu bytes of workspace (got %d, %zu)\n", (size_t)WS_END, n_in, ws_size); grid = -1; return; }
        int dev = 0, cus = 0, per_cu = 0;
        if (hipGetDevice(&dev) != hipSuccess || hipDeviceGetAttribute(&cus, hipDeviceAttributeMultiprocessorCount, dev) != hipSuccess) { grid = -1; return; }
        if (hipFuncSetAttribute((const void*)fwd_kernel, hipFuncAttributeMaxDynamicSharedMemorySize, LDS_BYTES) != hipSuccess) { fprintf(stderr, "kernel_launch: hipFuncSetAttribute failed\n"); grid = -1; return; }
        if (hipOccupancyMaxActiveBlocksPerMultiprocessor(&per_cu, (const void*)fwd_kernel, 512, LDS_BYTES) != hipSuccess || per_cu < 1) { fprintf(stderr, "kernel_launch: occupancy query says %d blocks per CU\n", per_cu); grid = -1; (void)hipGetLastError(); return; }
        grid = cus;
    }
    if (grid < 0) return;
    hipMemsetAsync((char*)d_ws + WS_CTL, 0, CTL_BYTES, stream);
    Args a{};
    for (int i = 0; i < 20; ++i) a.in[i] = (const float*)d_in[i];
    a.out = (float*)d_out; a.ws = (unsigned char*)d_ws; a.pad = 0;
#if N_LAUNCH_MODE == 0
    a.ph_lo = 0; a.ph_hi = PH_END; a.li = 0;
    hipLaunchKernelGGL(fwd_kernel, dim3(grid), dim3(512), LDS_BYTES, stream, a);
#else
    for (int p = 0; p < PH_END; ++p) { a.ph_lo = p; a.ph_hi = p + 1; a.li = p; hipLaunchKernelGGL(fwd_kernel, dim3(grid), dim3(512), LDS_BYTES, stream, a); }
#endif
}
```

```cpp
#include <hip/hip_runtime.h>
#include <cstdio>
#include <cstdint>

#ifndef TIMING
#define TIMING 0
#endif
#define PROBE_DOUBLE 0x000
#define NREP(k) (((PROBE_DOUBLE >> (k)) & 1) ? 2 : 1)
#define PROBE_EMPTY_EPI 0
#define TAIL_DIRECT 1
#define PREP_MODE 2
#define TIMING_A 0x004
#define TIMING_B 0x008
#define TIMING_BSCALE 10.0f

#define LAS __attribute__((address_space(3)))
typedef unsigned short bf16_t;
typedef short bf16x8 __attribute__((ext_vector_type(8)));
typedef float f32x4 __attribute__((ext_vector_type(4)));
typedef float f32x2 __attribute__((ext_vector_type(2)));
typedef float f32x16 __attribute__((ext_vector_type(16)));
typedef unsigned u32x4 __attribute__((ext_vector_type(4)));
typedef unsigned u32x2 __attribute__((ext_vector_type(2)));

constexpr int D = 2048, DFF = 5632, NREAL = 32768, MVALID = 32816, MPAD = 33024;
constexpr int NG = 128, NCH = 2051, NCHP = 2304;
constexpr int QKLD = 2560;
constexpr float RMS_EPS = 1e-6f;
constexpr float LOG2E = 1.4426950408889634f;

constexpr size_t MiB = 1u << 20;
constexpr size_t WS_CTL = 0, CTL_BYTES = 1 * MiB;
constexpr size_t WS_ROPE = 1 * MiB;
constexpr size_t ROPE_HALF = (size_t)16400 * 64 * 4;
constexpr size_t WS_SS = 10 * MiB;
constexpr size_t WS_A16 = 13 * MiB;
constexpr size_t WS_SST = WS_A16 + 512 * 1024;
constexpr size_t WS_W1 = 14 * MiB;
constexpr size_t WS_HB = 272 * MiB;
constexpr size_t WS_ACT = 401 * MiB;
constexpr size_t WS_VT = WS_ACT + 162 * MiB;
constexpr size_t WS_R2 = 756 * MiB;
constexpr size_t WS_W = 1044 * MiB;
constexpr size_t OW_WGU_A = 0, OW_WD_A = 44 * MiB, OW_WGU_B = 66 * MiB, OW_WD_B = 110 * MiB, OW_WMIX = 132 * MiB;
constexpr size_t WS_S5T = WS_W + 196 * MiB;
constexpr size_t S5T_PW_L = (size_t)NG * 2 * 64 * 17 * 2, S5T_BB_L = (size_t)NG * 2 * 64 * 16 * 2, S5T_BB_OFF = 2 * S5T_PW_L;
constexpr size_t WS_PART = WS_S5T + 10 * MiB;
constexpr size_t WS_END = WS_PART + 12 * MiB;
constexpr int CW_TICK = 180000;
constexpr size_t MIX_WGLU = 0, MIX_BMAT = 16 * MiB, MIX_WY = 32 * MiB;
constexpr size_t MIX_WQK = 0, MIX_WVT = 10 * MiB, MIX_WO = 12 * MiB;

constexpr int RING_BYTES = 131072, RED_OFF = 131072, MISC_OFF = 131072 + 4096, LDS_BYTES = 147456;
constexpr int INVC_OFF = MISC_OFF + 1024;

__device__ __forceinline__ unsigned cvt_pk_bf16(float lo, float hi) { unsigned r; asm volatile("v_cvt_pk_bf16_f32 %0, %1, %2" : "=v"(r) : "v"(lo), "v"(hi)); return r; }
__device__ __forceinline__ void unpack8(const u32x4 w, f32x4& a, f32x4& b) {
    a[0] = __builtin_bit_cast(float, w.x << 16); a[1] = __builtin_bit_cast(float, w.x & 0xffff0000u); a[2] = __builtin_bit_cast(float, w.y << 16); a[3] = __builtin_bit_cast(float, w.y & 0xffff0000u);
    b[0] = __builtin_bit_cast(float, w.z << 16); b[1] = __builtin_bit_cast(float, w.z & 0xffff0000u); b[2] = __builtin_bit_cast(float, w.w << 16); b[3] = __builtin_bit_cast(float, w.w & 0xffff0000u);
}
__device__ __forceinline__ float fast_exp2(float x) { return __builtin_amdgcn_exp2f(x); }
__device__ __forceinline__ float fast_rcp(float x) { return __builtin_amdgcn_rcpf(x); }
__device__ __forceinline__ float sigmoidf_(float x) { return fast_rcp(1.0f + fast_exp2(-x * LOG2E)); }
__device__ __forceinline__ float wave_sum(float v) {
#pragma unroll
    for (int o = 1; o < 64; o <<= 1) v += __shfl_xor(v, o);
    return v;
}
__device__ __forceinline__ float row_inv(const float* ss, int row, int nparts) {
    const f32x4* p = (const f32x4*)(ss + (size_t)row * 16);
    f32x4 a = p[0], b = p[1];
    float s = (a.x + a.y) + (a.z + a.w) + (b.x + b.y) + (b.z + b.w);
    if (nparts > 8) { f32x4 c = p[2], d = p[3]; s += (c.x + c.y) + (c.z + c.w) + (d.x + d.y) + (d.z + d.w); }
    return rsqrtf(s * (1.0f / D) + RMS_EPS);
}
__device__ __forceinline__ void row_inv8(const float* ss, int nparts, int row0, int fq, float (&inv)[2][4]) {
    const int lane = __builtin_amdgcn_mbcnt_hi(~0u, __builtin_amdgcn_mbcnt_lo(~0u, 0u));
    const int ai_ = fq >> 1, m0 = (fq & 1) * 2;
    const f32x4* pa = (const f32x4*)(ss + (size_t)(row0 + ai_ * 128 + m0 * 16) * 16); const f32x4* pb = pa + 64;
    const f32x4 a0 = pa[0], a1 = pa[1], a2 = pa[2], a3 = pa[3], b0 = pb[0], b1 = pb[1], b2 = pb[2], b3 = pb[3];
    float sa = (a0.x + a0.y) + (a0.z + a0.w) + (a1.x + a1.y) + (a1.z + a1.w), sb = (b0.x + b0.y) + (b0.z + b0.w) + (b1.x + b1.y) + (b1.z + b1.w);
    const float xa = (a2.x + a2.y) + (a2.z + a2.w) + (a3.x + a3.y) + (a3.z + a3.w), xb = (b2.x + b2.y) + (b2.z + b2.w) + (b3.x + b3.y) + (b3.z + b3.w);
    sa += nparts > 8 ? xa : 0.f; sb += nparts > 8 ? xb : 0.f;
    const float a = rsqrtf(sa * (1.0f / D) + RMS_EPS), b = rsqrtf(sb * (1.0f / D) + RMS_EPS);
#pragma unroll
    for (int ai = 0; ai < 2; ++ai)
#pragma unroll
        for (int m = 0; m < 4; ++m) { const int src = (lane & 15) + 16 * (2 * ai + (m >> 1)); const float va = __shfl(a, src), vb = __shfl(b, src); inv[ai][m] = (m & 1) ? vb : va; }
}
__device__ __forceinline__ int chunk_tok_row(int cr, int t) {
    const int s = cr >= 1026 ? 2 : (cr >= 513 ? 1 : 0);
    const int c = cr - (s == 2 ? 1026 : (s == 1 ? 513 : 0));
    const int rb = s == 2 ? 16384 : (s == 1 ? 8192 : 0);
    return c == 0 ? NREAL + 16 * s + t : rb + (c - 1) * 16 + t;
}
__device__ __forceinline__ size_t blk(int r, int k, int KT) { return ((size_t)((r >> 8) * KT + (k >> 6)) << 14) + (size_t)(((k >> 5) & 1) * 8192 + (r & 255) * 32 + (k & 31)); }
__device__ __forceinline__ int row_pos(int r) {
    if (r >= NREAL) return (r - NREAL) & 15;
    const int rb = r >= 16384 ? 16384 : (r >= 8192 ? 8192 : 0);
    return 16 + r - rb;
}

#define XB_TMO      128
#define XB_XCNT(j)  (256  + 64 * (j))
#define XB_XSUB(j)  (1280 + 64 * (j))
#define XB_XGEN(j)  (2304 + 64 * (j))
#define XB_TOP      3328
#define XB_TOPGEN   3392
#define XCD_BAR_WORDS 3456
#define XB_SPIN_CAP (1u << 20)

__device__ __forceinline__ unsigned xb_ld(unsigned* p)              { return __hip_atomic_load(p, __ATOMIC_RELAXED, __HIP_MEMORY_SCOPE_AGENT); }
__device__ __forceinline__ unsigned xb_add(unsigned* p, unsigned v) { return __hip_atomic_fetch_add(p, v, __ATOMIC_RELAXED, __HIP_MEMORY_SCOPE_AGENT); }
__device__ __forceinline__ unsigned xb_xcc_id() { return (unsigned)__builtin_amdgcn_s_getreg((3 << 11) | 20) & 0xFu; }
#define XB_SPIN(cond, bar) do { unsigned _sp = 0; while (cond) { __builtin_amdgcn_s_sleep(1); \
    if ((++_sp & 255u) == 0u) { if (xb_ld(&(bar)[XB_TMO])) break; if (_sp > XB_SPIN_CAP) { atomicAdd(&(bar)[XB_TMO], 1u); break; } } } } while (0)

struct XcdBarrier { unsigned* bar; unsigned x; volatile LAS unsigned* st; };

__device__ __forceinline__ XcdBarrier xcd_barrier_post(unsigned* bar, volatile LAS unsigned* st) {
    XcdBarrier b; b.bar = bar; b.x = xb_xcc_id(); b.st = st;
    if (threadIdx.x == 0) (void)xb_add(&bar[XB_XCNT(b.x)], 1u);
    return b;
}
__device__ __forceinline__ void xcd_barrier_complete(unsigned* bar, unsigned x, unsigned& nloc, unsigned& nx) {
    const unsigned G = gridDim.x * gridDim.y * gridDim.z;
    unsigned sum, cnt, mine, sp = 0u;
    for (;;) {
        sum = 0u; cnt = 0u; mine = 0u;
#pragma unroll
        for (unsigned j = 0; j < 16; ++j) { const unsigned c = xb_ld(&bar[XB_XCNT(j)]); sum += c; cnt += (c > 0u) ? 1u : 0u; mine = (j == x) ? c : mine; }
        if (sum == G) break;
        __builtin_amdgcn_s_sleep(1);
        if ((++sp & 255u) == 0u) { if (xb_ld(&bar[XB_TMO])) break; if (sp > XB_SPIN_CAP) { atomicAdd(&bar[XB_TMO], 1u); break; } }
    }
    nloc = mine > 0u ? mine : 1u; nx = cnt > 0u ? cnt : 1u;
}
__device__ __forceinline__ void xcd_barrier(const XcdBarrier& b) {
    asm volatile("s_waitcnt vmcnt(0)" ::: "memory");
    __syncthreads();
    if (threadIdx.x == 0) {
        unsigned* bar = b.bar;
        __builtin_amdgcn_s_waitcnt(0);
        unsigned nloc = b.st[0], nx = b.st[1];
        if (nloc == 0u) { xcd_barrier_complete(bar, b.x, nloc, nx); b.st[0] = nloc; b.st[1] = nx; }
        const unsigned old = xb_add(&bar[XB_XSUB(b.x)], 1u);
        const unsigned gen = old / nloc;
        if (old + 1u == (gen + 1u) * nloc) {
            __builtin_amdgcn_fence(__ATOMIC_RELEASE, "agent");
            asm volatile("s_waitcnt vmcnt(0)" ::: "memory");
            const unsigned og = xb_add(&bar[XB_TOP], 1u);
            const unsigned tg = og / nx;
            if (og + 1u == (tg + 1u) * nx) xb_add(&bar[XB_TOPGEN], 1u);
            else XB_SPIN(xb_ld(&bar[XB_TOPGEN]) == tg, bar);
            __builtin_amdgcn_fence(__ATOMIC_ACQUIRE, "agent");
            xb_add(&bar[XB_XGEN(b.x)], 1u);
            asm volatile("s_waitcnt vmcnt(0)" ::: "memory");
        } else {
            XB_SPIN(xb_ld(&bar[XB_XGEN(b.x)]) == gen, bar);
            __builtin_amdgcn_fence(__ATOMIC_ACQUIRE, "agent");
            asm volatile("s_waitcnt vmcnt(0)" ::: "memory");
        }
    }
    __syncthreads();
}

namespace pg8 {
constexpr int BM = 256, BK = 64, HALF = 128, HTB = HALF * BK * 2, STAGE_BYTES = 8 * HTB, NXCD = 8, WGM = 8;
__host__ __device__ __forceinline__ int lds_byte(int r, int c) { const int st = (r >> 4) * 2 + (c >> 5), rr = r & 15, cc = c & 31, ob = rr * 64 + cc * 2; return st * 1024 + (ob ^ (((ob >> 9) & 1) << 5)); }
__host__ __device__ __forceinline__ void stage_rc(int b, int& R, int& C) { const int st = b / 1024, sb = b % 1024, swz = sb ^ (((sb >> 9) & 1) << 5); R = (st >> 1) * 16 + swz / 64; C = (st & 1) * 32 + (swz % 64) / 2; }
__host__ __device__ __forceinline__ int perm32(int rho) { const int n = rho >> 4, i = rho & 15; return 8 * (i >> 2) + 4 * n + (i & 3); }

struct Unit { int pm, pn, thin, k0, sp; };
struct Gemm { const bf16_t* A; const bf16_t* Bt; int ktA, ktB, K; };

struct StaticOrder {
    int nM, nN, nwg, G, c, wgm;
    __device__ void init(int M, int N, int G_, int c_, int wgm_ = WGM) { nM = M / BM; nN = N / BM; nwg = nM * nN; G = G_; c = c_; wgm = wgm_; }
    __device__ bool next(int i, Unit& u) const {
        const long L = (long)i * G + c; if (L >= nwg) return false;
        int wgid = (int)L; { const int q = nwg / NXCD, r = nwg % NXCD, xcd = wgid % NXCD, off = wgid / NXCD; wgid = (xcd < r ? xcd * (q + 1) : r * (q + 1) + (xcd - r) * q) + off; }
        const int nig = wgm * nN, gid = wgid / nig, fm = gid * wgm, gsz = (nM - fm) < wgm ? (nM - fm) : wgm;
        u.pm = fm + ((wgid % nig) % gsz); u.pn = (wgid % nig) / gsz; u.thin = 0; u.k0 = 0; u.sp = 0; return true;
    }
};
struct TailOrder {
    int n, fixed, tmode, G, c;
    __device__ void init(int n_, int fixed_, int tmode_, int G_, int c_) { n = n_; fixed = fixed_; tmode = tmode_; G = G_; c = c_; }
    __device__ bool next(int i, Unit& u) const { const int L = i * G + c; if (L >= n) return false;
        if (tmode == 1) { u.pm = fixed; u.pn = L; u.thin = 1; } else { u.pm = L; u.pn = fixed; u.thin = 2; } u.k0 = 0; u.sp = 0; return true; }
};
struct SplitTailOrder {
    int n, nsplit, ktps, fixed, tmode, c;
    __device__ void init(int n_, int nsplit_, int ktps_, int fixed_, int tmode_, int c_) { n = n_; nsplit = nsplit_; ktps = ktps_; fixed = fixed_; tmode = tmode_; c = c_; }
    __device__ bool next(int i, Unit& u) const { if (i > 0) return false; const int q = c >> 3, slot = q / nsplit, sp = q - slot * nsplit, tile = slot * 8 + (c & 7); if (tile >= n) return false;
        if (tmode == 1) { u.pm = fixed; u.pn = tile; u.thin = 1; } else { u.pm = tile; u.pn = fixed; u.thin = 2; } u.k0 = sp * ktps; u.sp = sp; return true; }
};
struct BlockDiagOrder {
    int nwg, G, c;
    __device__ void init(int G_, int c_) { nwg = NG * 9; G = G_; c = c_; }
    __device__ bool next(int i, Unit& u) const { const int L = i * G + c; if (L >= nwg) return false;
        const int q = nwg / NXCD, r = nwg % NXCD, xcd = L % NXCD, off = L / NXCD; const int w = (xcd < r ? xcd * (q + 1) : r * (q + 1) + (xcd - r) * q) + off;
        u.pm = w; u.pn = w / 9; u.thin = 0; u.k0 = 0; u.sp = 0; return true; }
};

template <class Epi, class Sched, int THIN = 0>
__device__ __forceinline__ void gemm_phase(LAS unsigned char* lds, const Gemm g, const Sched& S, const Epi& E) {
    const int K = g.K, nt = K / BK;
    const int wid = __builtin_amdgcn_readfirstlane((int)threadIdx.x >> 6), wr = wid >> 2;
    unsigned voffA[2], voffB[2]; int aoff, boff;
#define PG8_LANE_SETUP() do { unsigned t_ = threadIdx.x; asm volatile("" : "+v"(t_)); const unsigned l_ = t_ & 63u, w_ = (unsigned)__builtin_amdgcn_readfirstlane((int)(t_ >> 6)); \
          \
        const unsigned swz_ = (l_ << 4) ^ ((l_ >> 5) << 5), R_ = (w_ >> 1) * 16u + (swz_ >> 6), Cl_ = (swz_ & 63u) >> 1, rho_ = R_ & 31u; \
        const unsigned Rb_ = Epi::PERM ? ((R_ & ~31u) + 8u * ((rho_ & 15u) >> 2) + 4u * (rho_ >> 4) + (rho_ & 3u)) : R_; \
        voffA[0] = ((w_ & 1u) * 8192u + R_ * 32u + Cl_) * 2u; voffA[1] = voffA[0] + 4096u; voffB[0] = ((w_ & 1u) * 8192u + Rb_ * 32u + Cl_) * 2u; voffB[1] = voffB[0] + 4096u; \
        const unsigned ob_ = (l_ & 15u) * 64u + (l_ >> 4) * 16u, lp_ = ob_ ^ (((l_ >> 3) & 1u) << 5); \
        aoff = (int)((w_ >> 2) * 8192u + lp_); boff = (int)((w_ & 3u) * 4096u + lp_); } while (0)
    PG8_LANE_SETUP();
    const size_t kstep = (size_t)32768;
    const size_t hstepA = (size_t)8192, hstepB = (size_t)8192;
    const size_t tstepA = (size_t)g.ktA * 32768, tstepB = (size_t)g.ktB * 32768;
    const unsigned ldsw = (unsigned)wid * 1024u;
#define PG8_SA(b, h) (((b) * 2 + (h)) * HTB)
#define PG8_SB(b, h) ((4 + (b) * 2 + (h)) * HTB)
#define PG8_STAGE(bufoff, gbase, voff) do { _Pragma("unroll") for (int _i = 0; _i < 2; ++_i) { unsigned keep_; \
        asm volatile("s_mov_b32 %0, m0\n\ts_mov_b32 m0, %3\n\ts_nop 0\n\tglobal_load_lds_dwordx4 %1, %2\n\ts_mov_b32 m0, %0" \
            : "=&s"(keep_) : "v"((voff)[_i]), "s"((const char*)(gbase)), "s"((unsigned)(size_t)(lds + (bufoff) + ldsw + _i * 8192)) : "memory"); } } while (0)
#define PG8_LDA(dst, b, h) do { if (THIN == 3) break; _Pragma("unroll") for (int m = 0; m < 4; ++m) _Pragma("unroll") for (int k = 0; k < 2; ++k) dst[m][k] = *(const LAS bf16x8*)(lds + PG8_SA(b, h) + aoff + m * 2048 + k * 1024); } while (0)
#define PG8_LDB(dst, b, h) do { if (THIN == 3) break; _Pragma("unroll") for (int n = 0; n < 2; ++n) _Pragma("unroll") for (int k = 0; k < 2; ++k) dst[n][k] = *(const LAS bf16x8*)(lds + PG8_SB(b, h) + boff + n * 2048 + k * 1024); } while (0)
#define PG8_MMA(ai, bj, At, Bt) do { if (THIN == 0 || ((mm >> ((ai) * 2 + (bj))) & 1)) { __builtin_amdgcn_s_setprio(1); _Pragma("unroll") for (int m = 0; m < 4; ++m) _Pragma("unroll") for (int n = 0; n < 2; ++n) _Pragma("unroll") for (int k = 0; k < 2; ++k) \
        acc[ai][bj][m][n] = __builtin_amdgcn_mfma_f32_16x16x32_bf16(Bt[n][k], At[m][k], acc[ai][bj][m][n], 0, 0, 0); __builtin_amdgcn_s_setprio(0); } } while (0)
#define PG8_MMAF(ai, bj, At, Bt) do { if (THIN == 0 && first) { __builtin_amdgcn_s_setprio(1); \
        _Pragma("unroll") for (int m = 0; m < 4; ++m) _Pragma("unroll") for (int n = 0; n < 2; ++n) acc[ai][bj][m][n] = __builtin_amdgcn_mfma_f32_16x16x32_bf16(Bt[n][0], At[m][0], (f32x4){0.f, 0.f, 0.f, 0.f}, 0, 0, 0); \
        _Pragma("unroll") for (int m = 0; m < 4; ++m) _Pragma("unroll") for (int n = 0; n < 2; ++n) acc[ai][bj][m][n] = __builtin_amdgcn_mfma_f32_16x16x32_bf16(Bt[n][1], At[m][1], acc[ai][bj][m][n], 0, 0, 0); \
        __builtin_amdgcn_s_setprio(0); } else PG8_MMA(ai, bj, At, Bt); } while (0)
#define PG8_MM(u) (THIN == 0 ? 0xF : (THIN == 3 ? 0x0 : (THIN == 1 ? (wr == 0 ? 0x3 : 0x0) : (((wid & 3) < 2) ? 0x5 : 0x0))))
#define PG8_WAIT_V(n) asm volatile("s_waitcnt vmcnt(" #n ")" ::: "memory")
#define PG8_WAIT_L(n) asm volatile("s_waitcnt lgkmcnt(" #n ")" ::: "memory")
#define PG8_BAR __builtin_amdgcn_s_barrier()
#define PG8_SCHED __builtin_amdgcn_sched_barrier(0)
    Unit cur, nxt; int ui = 0;
    if (!S.next(0, cur)) return;
    int mm = PG8_MM(cur);
    int pre_pm = -1, pre_buf = 0;
    if constexpr (Epi::PRE) { pre_buf ^= 1; E.pre(cur.pm, pre_buf); pre_pm = cur.pm; }
    f32x4 acc[2][2][4][2];
#pragma unroll
    for (int a = 0; a < 2; ++a)
#pragma unroll
        for (int b = 0; b < 2; ++b)
#pragma unroll
            for (int m = 0; m < 4; ++m)
#pragma unroll
                for (int n = 0; n < 2; ++n) { if (THIN == 0) asm volatile("" : "=v"(acc[a][b][m][n])); else acc[a][b][m][n] = (f32x4){0.f, 0.f, 0.f, 0.f}; }
    bf16x8 At[4][2] = {}, B0[2][2] = {}, B1[2][2] = {};
    const char* cA = (const char*)g.A + (size_t)cur.pm * tstepA + (size_t)cur.k0 * kstep; const char* cB = (const char*)g.Bt + (size_t)cur.pn * tstepB + (size_t)cur.k0 * kstep;
#define PG8_LEAN (THIN == 1)
#define PG8_WAIT_K() do { if (PG8_LEAN) PG8_WAIT_V(6); else PG8_WAIT_V(8); } while (0)
#define PG8_RD (!PG8_LEAN || wr == 0)
    PG8_STAGE(PG8_SB(0, 0), cB, voffB); PG8_STAGE(PG8_SB(0, 1), cB + hstepB, voffB); PG8_STAGE(PG8_SA(0, 0), cA, voffA); if (!PG8_LEAN) PG8_STAGE(PG8_SA(0, 1), cA + hstepA, voffA);
    if (wr == 1) PG8_BAR;
    if (PG8_LEAN) PG8_WAIT_V(0); else PG8_WAIT_V(2);
    PG8_BAR;
    PG8_STAGE(PG8_SB(1, 0), cB + kstep, voffB); PG8_STAGE(PG8_SA(1, 0), cA + kstep, voffA); PG8_STAGE(PG8_SB(1, 1), cB + hstepB + kstep, voffB);
    PG8_WAIT_V(6); PG8_BAR;
    for (;;) {
        const bool has_next = S.next(ui + 1, nxt);
        const char* nA = has_next ? (const char*)g.A + (size_t)nxt.pm * tstepA + (size_t)nxt.k0 * kstep : cA; const char* nB = has_next ? (const char*)g.Bt + (size_t)nxt.pn * tstepB + (size_t)nxt.k0 * kstep : cB;
        for (int t = 0; t < nt; t += 2) {
            const bool last = (t == nt - 2), first = (t == 0);
            const char* a1 = cA + (size_t)(t + 1) * kstep;
            const char* a2 = last ? nA : cA + (size_t)(t + 2) * kstep; const char* b2 = last ? nB : cB + (size_t)(t + 2) * kstep;
            const char* a3 = a2 + kstep; const char* b3 = b2 + kstep;
            if (PG8_RD) { PG8_LDB(B0, 0, 0); PG8_LDB(B1, 0, 1); PG8_SCHED; PG8_LDA(At, 0, 0); } if (!PG8_LEAN) PG8_STAGE(PG8_SA(1, 1), a1 + hstepA, voffA);
            PG8_WAIT_K(); PG8_WAIT_L(0); PG8_BAR; PG8_MMAF(0, 0, At, B0); PG8_MMAF(0, 1, At, B1); PG8_BAR; PG8_SCHED;
            if (!PG8_LEAN) PG8_LDA(At, 0, 1); PG8_STAGE(PG8_SB(0, 0), b2, voffB); PG8_STAGE(PG8_SB(0, 1), b2 + hstepB, voffB); PG8_STAGE(PG8_SA(0, 0), a2, voffA);
            PG8_WAIT_K(); PG8_WAIT_L(0); PG8_BAR; PG8_MMAF(1, 0, At, B0); PG8_MMAF(1, 1, At, B1); PG8_BAR; PG8_SCHED;
            if (PG8_RD) { PG8_LDB(B0, 1, 0); PG8_LDB(B1, 1, 1); PG8_SCHED; PG8_LDA(At, 1, 0); } if (!PG8_LEAN) PG8_STAGE(PG8_SA(0, 1), a2 + hstepA, voffA);
            PG8_WAIT_K(); PG8_WAIT_L(0); PG8_BAR; PG8_MMA(0, 0, At, B0); PG8_MMA(0, 1, At, B1); PG8_BAR; PG8_SCHED;
            if (!PG8_LEAN) PG8_LDA(At, 1, 1); PG8_STAGE(PG8_SB(1, 0), b3, voffB); PG8_STAGE(PG8_SB(1, 1), b3 + hstepB, voffB); PG8_STAGE(PG8_SA(1, 0), a3, voffA);
            PG8_WAIT_K(); PG8_WAIT_L(0); PG8_BAR; PG8_MMA(1, 0, At, B0); PG8_MMA(1, 1, At, B1); PG8_BAR; PG8_SCHED;
        }
        if constexpr (Epi::PRE) {
            int t_ = threadIdx.x; asm volatile("" : "+v"(t_)); const int l_ = t_ & 63, w_ = __builtin_amdgcn_readfirstlane(t_ >> 6);
            if (wr == 0) { E(acc, cur, w_ >> 2, w_ & 3, l_ & 15, l_ >> 4, pre_buf, 0, 1); PG8_BAR; E(acc, cur, w_ >> 2, w_ & 3, l_ & 15, l_ >> 4, pre_buf, 1, 2); }
            else E(acc, cur, w_ >> 2, w_ & 3, l_ & 15, l_ >> 4, pre_buf, 0, 2);
        } else {
        if (wr == 0) PG8_BAR;
        { int t_ = threadIdx.x; asm volatile("" : "+v"(t_)); const int l_ = t_ & 63, w_ = __builtin_amdgcn_readfirstlane(t_ >> 6);
          E(acc, cur, w_ >> 2, w_ & 3, l_ & 15, l_ >> 4); }
        }
        if (!has_next) break;
        if constexpr (Epi::PRE) { if (nxt.pm != pre_pm) { pre_buf ^= 1; E.pre(nxt.pm, pre_buf); pre_pm = nxt.pm; } }
        PG8_LANE_SETUP();
        if (THIN != 0) {
#pragma unroll
        for (int a = 0; a < 2; ++a)
#pragma unroll
            for (int b = 0; b < 2; ++b)
#pragma unroll
                for (int m = 0; m < 4; ++m)
#pragma unroll
                    for (int n = 0; n < 2; ++n) acc[a][b][m][n] = (f32x4){0.f, 0.f, 0.f, 0.f};
        }
        cur = nxt; cA = nA; cB = nB; ++ui; mm = PG8_MM(cur);
        if (wr == 1) PG8_BAR;
    }
    PG8_WAIT_V(0);
    PG8_BAR;
#undef PG8_LANE_SETUP
#undef PG8_LEAN
#undef PG8_WAIT_K
#undef PG8_RD
#undef PG8_MM
#undef PG8_SA
#undef PG8_SB
#undef PG8_STAGE
#undef PG8_LDA
#undef PG8_LDB
#undef PG8_MMA
#undef PG8_MMAF
#undef PG8_WAIT_V
#undef PG8_WAIT_L
#undef PG8_BAR
#undef PG8_SCHED
}

template <class Epi, class Sched>
__device__ __forceinline__ void gemm_phase2(LAS unsigned char* lds, const Gemm g, const Sched& S, const Epi& E) {
    const int K = g.K, nt = K / BK;
    const int wid = __builtin_amdgcn_readfirstlane((int)threadIdx.x >> 6), wr = wid >> 2;
    unsigned voffA[2], voffB[2]; int aoff, boff;
#define P2_LANE_SETUP() do { int t_ = threadIdx.x; asm volatile("" : "+v"(t_)); const int l_ = t_ & 63, w_ = __builtin_amdgcn_readfirstlane(t_ >> 6); \
        const int sb_ = l_ * 16, sw_ = sb_ ^ (((sb_ >> 9) & 1) << 5), rr_ = sw_ >> 6, cc_ = (sw_ & 63) >> 1; \
        _Pragma("unroll") for (int i = 0; i < 2; ++i) { const int R = 16 * (w_ + 8 * i) + rr_; const int Rb = Epi::PERM ? ((R & ~31) + perm32(R & 31)) : R; \
            voffA[i] = (unsigned)(R * 32 + cc_) * 2u; voffB[i] = (unsigned)(Rb * 32 + cc_) * 2u; } \
        const int ob_ = (l_ & 15) * 64 + (l_ >> 4) * 16, in_ = ob_ ^ (((ob_ >> 9) & 1) << 5); \
        aoff = (w_ >> 2) * 4096 + in_; boff = (w_ & 3) * 2048 + in_; } while (0)
    P2_LANE_SETUP();
    const size_t kstep = (size_t)32768;
    const size_t tstepA = (size_t)g.ktA * 32768, tstepB = (size_t)g.ktB * 32768;
    const unsigned ldsw = (unsigned)wid * 1024u;
#define P2_XA(b, kh) ((((b) * 2 + (kh)) * 2 + 0) * 16384)
#define P2_XB(b, kh) ((((b) * 2 + (kh)) * 2 + 1) * 16384)
#define P2_STAGE1(bufoff, gbase, voff) do { _Pragma("unroll") for (int _i = 0; _i < 2; ++_i) { unsigned keep_; \
        asm volatile("s_mov_b32 %0, m0\n\ts_mov_b32 m0, %3\n\ts_nop 0\n\tglobal_load_lds_dwordx4 %1, %2\n\ts_mov_b32 m0, %0" \
            : "=&s"(keep_) : "v"((voff)[_i]), "s"((const char*)(gbase)), "s"((unsigned)(size_t)(lds + (bufoff) + ldsw + _i * 8192)) : "memory"); } } while (0)
#define P2_STAGE(b, kh, ga, gb) do { P2_STAGE1(P2_XB(b, kh), (gb) + (kh) * 16384, voffB); P2_STAGE1(P2_XA(b, kh), (ga) + (kh) * 16384, voffA); } while (0)
#define P2_READ(b, kh) do { _Pragma("unroll") for (int bj = 0; bj < 2; ++bj) _Pragma("unroll") for (int n = 0; n < 2; ++n) Bf[bj][n] = *(const LAS bf16x8*)(lds + P2_XB(b, kh) + boff + (bj * 8 + n) * 1024); \
        __builtin_amdgcn_sched_barrier(0); \
        _Pragma("unroll") for (int ai = 0; ai < 2; ++ai) _Pragma("unroll") for (int m = 0; m < 4; ++m) Af[ai][m] = *(const LAS bf16x8*)(lds + P2_XA(b, kh) + aoff + (ai * 8 + m) * 1024); } while (0)
#define P2_MMA() do { __builtin_amdgcn_s_setprio(1); _Pragma("unroll") for (int ai = 0; ai < 2; ++ai) _Pragma("unroll") for (int bj = 0; bj < 2; ++bj) _Pragma("unroll") for (int m = 0; m < 4; ++m) _Pragma("unroll") for (int n = 0; n < 2; ++n) \
        acc[ai][bj][m][n] = __builtin_amdgcn_mfma_f32_16x16x32_bf16(Bf[bj][n], Af[ai][m], acc[ai][bj][m][n], 0, 0, 0); __builtin_amdgcn_s_setprio(0); } while (0)
#define P2_WAIT_V(n) asm volatile("s_waitcnt vmcnt(" #n ")" ::: "memory")
#define P2_WAIT_L0() asm volatile("s_waitcnt lgkmcnt(0)" ::: "memory")
#define P2_BAR __builtin_amdgcn_s_barrier()
#define P2_SCHED __builtin_amdgcn_sched_barrier(0)
    Unit cur, nxt; int ui = 0;
    if (!S.next(0, cur)) return;
    f32x4 acc[2][2][4][2];
#pragma unroll
    for (int a = 0; a < 2; ++a)
#pragma unroll
        for (int b = 0; b < 2; ++b)
#pragma unroll
            for (int m = 0; m < 4; ++m)
#pragma unroll
                for (int n = 0; n < 2; ++n) acc[a][b][m][n] = (f32x4){0.f, 0.f, 0.f, 0.f};
    bf16x8 Af[2][4], Bf[2][2];
    const char* cA = (const char*)g.A + (size_t)cur.pm * tstepA + (size_t)cur.k0 * kstep; const char* cB = (const char*)g.Bt + (size_t)cur.pn * tstepB + (size_t)cur.k0 * kstep;
    P2_STAGE(0, 0, cA, cB); P2_STAGE(0, 1, cA, cB);
    if (wr == 1) P2_BAR;
    P2_WAIT_V(4); P2_BAR;
    P2_STAGE(1, 0, cA + kstep, cB + kstep);
    P2_WAIT_V(8); P2_BAR;
    for (;;) {
        const bool has_next = S.next(ui + 1, nxt);
        const char* nA = has_next ? (const char*)g.A + (size_t)nxt.pm * tstepA + (size_t)nxt.k0 * kstep : cA; const char* nB = has_next ? (const char*)g.Bt + (size_t)nxt.pn * tstepB + (size_t)nxt.k0 * kstep : cB;
        for (int t = 0; t < nt; t += 2) {
            const bool last = (t == nt - 2);
            const char* a1 = cA + (size_t)(t + 1) * kstep; const char* b1 = cB + (size_t)(t + 1) * kstep;
            const char* a2 = last ? nA : cA + (size_t)(t + 2) * kstep; const char* b2 = last ? nB : cB + (size_t)(t + 2) * kstep;
            const char* a3 = a2 + kstep; const char* b3 = b2 + kstep;
            P2_READ(0, 0); P2_STAGE(1, 1, a1, b1);
            P2_WAIT_V(8); P2_WAIT_L0(); P2_BAR; P2_MMA(); P2_BAR; P2_SCHED;
            P2_READ(0, 1); P2_STAGE(0, 0, a2, b2);
            P2_WAIT_V(8); P2_WAIT_L0(); P2_BAR; P2_MMA(); P2_BAR; P2_SCHED;
            P2_READ(1, 0); P2_STAGE(0, 1, a2, b2);
            P2_WAIT_V(8); P2_WAIT_L0(); P2_BAR; P2_MMA(); P2_BAR; P2_SCHED;
            P2_READ(1, 1); P2_STAGE(1, 0, a3, b3);
            P2_WAIT_V(8); P2_WAIT_L0(); P2_BAR; P2_MMA(); P2_BAR; P2_SCHED;
        }
        if (wr == 0) P2_BAR;
        { int t_ = threadIdx.x; asm volatile("" : "+v"(t_)); const int l_ = t_ & 63, w_ = __builtin_amdgcn_readfirstlane(t_ >> 6);
          E(acc, cur, w_ >> 2, w_ & 3, l_ & 15, l_ >> 4); }
        if (!has_next) break;
        P2_LANE_SETUP();
#pragma unroll
        for (int a = 0; a < 2; ++a)
#pragma unroll
            for (int b = 0; b < 2; ++b)
#pragma unroll
                for (int m = 0; m < 4; ++m)
#pragma unroll
                    for (int n = 0; n < 2; ++n) acc[a][b][m][n] = (f32x4){0.f, 0.f, 0.f, 0.f};
        cur = nxt; cA = nA; cB = nB; ++ui;
        if (wr == 1) P2_BAR;
    }
    P2_WAIT_V(0);
    P2_BAR;
#undef P2_LANE_SETUP
#undef P2_XA
#undef P2_XB
#undef P2_STAGE1
#undef P2_STAGE
#undef P2_READ
#undef P2_MMA
#undef P2_WAIT_V
#undef P2_WAIT_L0
#undef P2_BAR
#undef P2_SCHED
}
}
using pg8::Unit;


struct EpiSwiGLU {
    static constexpr bool PERM = true;
    static constexpr bool PRE = true;
    bf16_t* act; const float* ss; int nparts; LAS unsigned char* lds;
    __device__ __forceinline__ void pre(int pm, int buf) const {
        int t = threadIdx.x; asm volatile("" : "+v"(t));
        if (t < 256) { const int np = nparts < 0 ? 8 : nparts; const f32x4* p = (const f32x4*)(ss + (size_t)(pm * 256 + t) * 16);
            const f32x4 a = p[0], b = p[1]; float sq = (a.x + a.y) + (a.z + a.w) + (b.x + b.y) + (b.z + b.w);
            if (np > 8) { const f32x4 c = p[2], d = p[3]; sq += (c.x + c.y) + (c.z + c.w) + (d.x + d.y) + (d.z + d.w); }
            const float ms = sq * (1.0f / D) + RMS_EPS;
            ((LAS f32x2*)(lds + INVC_OFF))[buf * 256 + t] = (f32x2){rsqrtf(ms), ms}; }
    }
    __device__ __forceinline__ void operator()(const f32x4 (&acc)[2][2][4][2], const Unit& u, int wr, int wc, int fr, int fq, int buf, int ai_lo, int ai_hi) const {
        if (PROBE_EMPTY_EPI && nparts < 0) return;
        const int row0 = u.pm * 256 + wr * 64 + fr, col0 = u.pn * 128 + wc * 32 + 8 * fq;
        const LAS f32x2* ic = (const LAS f32x2*)(lds + INVC_OFF) + buf * 256 + wr * 64 + fr;
#pragma unroll
        for (int ai = 0; ai < 2; ++ai)
#pragma unroll
            for (int m = 0; m < 4; ++m) {
                if (ai < ai_lo || ai >= ai_hi) continue;
                if (u.thin == 1 && (wr | ai)) continue;
                const int r = row0 + ai * 128 + m * 16; const f32x2 iv = ic[ai * 128 + m * 16];
                const float c1 = -LOG2E * iv.x; const f32x2 c1v = {c1, c1}, msv = {iv.y, iv.y};
                f32x2 o[4];
#pragma unroll
                for (int n = 0; n < 2; ++n)
#pragma unroll
                    for (int jp = 0; jp < 2; ++jp) {
                        const f32x2 g = {acc[ai][0][m][n][2 * jp], acc[ai][0][m][n][2 * jp + 1]}, up = {acc[ai][1][m][n][2 * jp], acc[ai][1][m][n][2 * jp + 1]};
                        const f32x2 t = g * c1v; const f32x2 e = {fast_exp2(t.x), fast_exp2(t.y)}; const f32x2 d = e * msv + msv; const f32x2 rc = {fast_rcp(d.x), fast_rcp(d.y)};
                        o[n * 2 + jp] = (g * up) * rc;
                    }
                u32x4 w; w.x = cvt_pk_bf16(o[0].x, o[0].y); w.y = cvt_pk_bf16(o[1].x, o[1].y); w.z = cvt_pk_bf16(o[2].x, o[2].y); w.w = cvt_pk_bf16(o[3].x, o[3].y);
                __builtin_nontemporal_store(w, (u32x4*)(act + blk(r, col0, DFF / 64)));
            }
    }
};

struct EpiResid {
    static constexpr bool PRE = false;
    static constexpr bool PERM = true;
    bf16_t* hb; float* ss; float scale; LAS float* red;
    __device__ __forceinline__ void operator()(const f32x4 (&acc)[2][2][4][2], const Unit& u, int wr, int wc, int fr, int fq) const {
        if (PROBE_EMPTY_EPI && scale == 0.0f) return;
        const int row0 = u.pm * 256 + wr * 64 + fr, col0 = u.pn * 256 + wc * 32 + 8 * fq;
        float rs[2][4];
#pragma unroll
        for (int ai = 0; ai < 2; ++ai) {
            if (u.thin == 1 && (wr | ai)) {
#pragma unroll
                for (int m = 0; m < 4; ++m) rs[ai][m] = 0.f;
                continue; }
            u32x4 hv[4][2];
#pragma unroll
            for (int m = 0; m < 4; ++m)
#pragma unroll
                for (int bj = 0; bj < 2; ++bj) hv[m][bj] = *(const u32x4*)(hb + blk(row0 + ai * 128 + m * 16, col0 + bj * 128, D / 64));
#pragma unroll
            for (int m = 0; m < 4; ++m) {
                const int ri = row0 + ai * 128 + m * 16; float s = 0.f;
#pragma unroll
                for (int bj = 0; bj < 2; ++bj) {
                    bf16_t* bp = hb + blk(ri, col0 + bj * 128, D / 64);
                    f32x4 v0, v1; unpack8(hv[m][bj], v0, v1);
                    v0 += scale * acc[ai][bj][m][0]; v1 += scale * acc[ai][bj][m][1];
                    u32x4 w; w.x = cvt_pk_bf16(v0[0], v0[1]); w.y = cvt_pk_bf16(v0[2], v0[3]); w.z = cvt_pk_bf16(v1[0], v1[1]); w.w = cvt_pk_bf16(v1[2], v1[3]);
                    *(u32x4*)bp = w;
                    s += (v0[0] * v0[0] + v0[1] * v0[1]) + (v0[2] * v0[2] + v0[3] * v0[3]) + (v1[0] * v1[0] + v1[1] * v1[1]) + (v1[2] * v1[2] + v1[3] * v1[3]);
                }
                rs[ai][m] = s;
            }
        }
#pragma unroll
        for (int ai = 0; ai < 2; ++ai)
#pragma unroll
            for (int m = 0; m < 4; ++m) { float s = rs[ai][m]; s += __shfl_xor(s, 16); s += __shfl_xor(s, 32); if (fq == 0) red[(ai * 128 + wr * 64 + m * 16 + fr) * 4 + wc] = s; }
        asm volatile("s_waitcnt lgkmcnt(0)" ::: "memory"); __builtin_amdgcn_s_barrier(); asm volatile("" ::: "memory");
        const int tid = (wr * 4 + wc) * 64 + fq * 16 + fr;
        if (tid < (u.thin == 1 ? 64 : 256)) { const f32x4 v = *(const LAS f32x4*)(red + tid * 4); ss[(size_t)(u.pm * 256 + tid) * 16 + u.pn] = (v.x + v.y) + (v.z + v.w); }
    }
};

struct EpiGLU {
    static constexpr bool PRE = false;
    static constexpr bool PERM = true;
    bf16_t* hb; float* ss; float scale; LAS float* red;
    __device__ __forceinline__ void operator()(const f32x4 (&acc)[2][2][4][2], const Unit& u, int wr, int wc, int fr, int fq) const {
        const int row0 = u.pm * 256 + wr * 64 + fr, col0 = u.pn * 128 + wc * 32 + 8 * fq;
        float rs[2][4];
#pragma unroll
        for (int ai = 0; ai < 2; ++ai) {
            if (u.thin == 1 && (wr | ai)) {
#pragma unroll
                for (int m = 0; m < 4; ++m) rs[ai][m] = 0.f;
                continue; }
            u32x4 hv[4];
#pragma unroll
            for (int m = 0; m < 4; ++m) hv[m] = *(const u32x4*)(hb + blk(row0 + ai * 128 + m * 16, col0, D / 64));
#pragma unroll
            for (int m = 0; m < 4; ++m) {
                const int ri = row0 + ai * 128 + m * 16; bf16_t* bp = hb + blk(ri, col0, D / 64);
                f32x4 v0, v1; unpack8(hv[m], v0, v1);
#pragma unroll
                for (int j = 0; j < 4; ++j) { v0[j] += scale * acc[ai][0][m][0][j] * sigmoidf_(acc[ai][1][m][0][j]); v1[j] += scale * acc[ai][0][m][1][j] * sigmoidf_(acc[ai][1][m][1][j]); }
                u32x4 w; w.x = cvt_pk_bf16(v0[0], v0[1]); w.y = cvt_pk_bf16(v0[2], v0[3]); w.z = cvt_pk_bf16(v1[0], v1[1]); w.w = cvt_pk_bf16(v1[2], v1[3]);
                *(u32x4*)bp = w;
                rs[ai][m] = (v0[0] * v0[0] + v0[1] * v0[1]) + (v0[2] * v0[2] + v0[3] * v0[3]) + (v1[0] * v1[0] + v1[1] * v1[1]) + (v1[2] * v1[2] + v1[3] * v1[3]);
            }
        }
#pragma unroll
        for (int ai = 0; ai < 2; ++ai)
#pragma unroll
            for (int m = 0; m < 4; ++m) { float s = rs[ai][m]; s += __shfl_xor(s, 16); s += __shfl_xor(s, 32); if (fq == 0) red[(ai * 128 + wr * 64 + m * 16 + fr) * 4 + wc] = s; }
        asm volatile("s_waitcnt lgkmcnt(0)" ::: "memory"); __builtin_amdgcn_s_barrier(); asm volatile("" ::: "memory");
        const int tid = (wr * 4 + wc) * 64 + fq * 16 + fr;
        if (tid < (u.thin == 1 ? 64 : 256)) { const f32x4 v = *(const LAS f32x4*)(red + tid * 4); ss[(size_t)(u.pm * 256 + tid) * 16 + u.pn] = (v.x + v.y) + (v.z + v.w); }
    }
};

struct EpiQK {
    static constexpr bool PRE = false;
    static constexpr bool PERM = true;
    bf16_t* qk; const float* ss; int nparts; const float* ropec; const float* ropes; float qscale;
    __device__ __forceinline__ void operator()(const f32x4 (&acc)[2][2][4][2], const Unit& u, int wr, int wc, int fr, int fq) const {
        const int row0 = u.pm * 256 + wr * 64 + fr;
        const int which = wc >> 1, i0 = 32 * (wc & 1) + 8 * fq;
        const int head = 2 * u.pn + which;
        float inv8[2][4]; row_inv8(ss, nparts, row0, fq, inv8);
        const float sc = __builtin_bit_cast(float, __builtin_amdgcn_readfirstlane(u.pn < 8 ? __builtin_bit_cast(int, qscale) : 0x3f800000));
#pragma unroll
        for (int ai = 0; ai < 2; ++ai)
#pragma unroll
            for (int mp = 0; mp < 4; mp += 2) {
                if (u.thin == 1 && (wr | ai)) continue;
                f32x4 cs[2][4];
#pragma unroll
                for (int q = 0; q < 2; ++q) { const int pos = row_pos(row0 + ai * 128 + (mp + q) * 16);
                    cs[q][0] = *(const f32x4*)(ropec + pos * 64 + i0); cs[q][1] = *(const f32x4*)(ropec + pos * 64 + i0 + 4);
                    cs[q][2] = *(const f32x4*)(ropes + pos * 64 + i0); cs[q][3] = *(const f32x4*)(ropes + pos * 64 + i0 + 4); }
#pragma unroll
                for (int q = 0; q < 2; ++q) {
                    const int m = mp + q, r = row0 + ai * 128 + m * 16; const float inv = inv8[ai][m] * sc;
                    const f32x4 c0 = cs[q][0], c1 = cs[q][1], s0 = cs[q][2], s1 = cs[q][3];
                    float o1[8], o2[8];
#pragma unroll
                    for (int j = 0; j < 4; ++j) {
                        const float xa = acc[ai][0][m][0][j] * inv, xb = acc[ai][1][m][0][j] * inv; o1[j] = xa * c0[j] - xb * s0[j]; o2[j] = xb * c0[j] + xa * s0[j];
                        const float ya = acc[ai][0][m][1][j] * inv, yb = acc[ai][1][m][1][j] * inv; o1[4 + j] = ya * c1[j] - yb * s1[j]; o2[4 + j] = yb * c1[j] + ya * s1[j];
                    }
                    bf16_t* op = qk + (size_t)r * QKLD + head * 128 + i0;
                    u32x4 w; w.x = cvt_pk_bf16(o1[0], o1[1]); w.y = cvt_pk_bf16(o1[2], o1[3]); w.z = cvt_pk_bf16(o1[4], o1[5]); w.w = cvt_pk_bf16(o1[6], o1[7]);
                    *(u32x4*)(op) = w;
                    w.x = cvt_pk_bf16(o2[0], o2[1]); w.y = cvt_pk_bf16(o2[2], o2[3]); w.z = cvt_pk_bf16(o2[4], o2[5]); w.w = cvt_pk_bf16(o2[6], o2[7]);
                    *(u32x4*)(op + 64) = w;
                }
            }
    }
};

struct EpiVt {
    static constexpr bool PRE = false;
    static constexpr bool PERM = true;
    bf16_t* vt; const float* ss; int nparts;
    __device__ __forceinline__ void operator()(const f32x4 (&acc)[2][2][4][2], const Unit& u, int wr, int wc, int fr, int fq) const {
        const int row0 = u.pm * 256 + wr * 64 + fr, col0 = u.pn * 256 + wc * 32 + 8 * fq;
#pragma unroll
        for (int bj = 0; bj < 2; ++bj) {
            if (u.thin == 2 && (bj | (wc >> 1))) continue;
            float inv[8];
            {
                const f32x4* p = (const f32x4*)(ss + (size_t)(col0 + bj * 128) * 16);
#pragma unroll
                for (int jb = 0; jb < 8; jb += 4) {
                    f32x4 q[4][4];
#pragma unroll
                    for (int j = 0; j < 4; ++j)
#pragma unroll
                        for (int x = 0; x < 4; ++x) q[j][x] = p[(jb + j) * 4 + x];
#pragma unroll
                    for (int j = 0; j < 4; ++j) { float sa = (q[j][0].x + q[j][0].y) + (q[j][0].z + q[j][0].w) + (q[j][1].x + q[j][1].y) + (q[j][1].z + q[j][1].w);
                        const float xa = (q[j][2].x + q[j][2].y) + (q[j][2].z + q[j][2].w) + (q[j][3].x + q[j][3].y) + (q[j][3].z + q[j][3].w);
                        sa += nparts > 8 ? xa : 0.f; inv[jb + j] = rsqrtf(sa * (1.0f / D) + RMS_EPS); }
                }
            }
#pragma unroll
            for (int ai = 0; ai < 2; ++ai)
#pragma unroll
                for (int m = 0; m < 4; ++m) {
                    const int r = row0 + ai * 128 + m * 16;
                    const f32x4 a = acc[ai][bj][m][0], b = acc[ai][bj][m][1];
                    u32x4 w; w.x = cvt_pk_bf16(a[0] * inv[0], a[1] * inv[1]); w.y = cvt_pk_bf16(a[2] * inv[2], a[3] * inv[3]); w.z = cvt_pk_bf16(b[0] * inv[4], b[1] * inv[5]); w.w = cvt_pk_bf16(b[2] * inv[6], b[3] * inv[7]);
                    *(u32x4*)(vt + (size_t)r * MPAD + col0 + bj * 128) = w;
                }
        }
    }
};

struct EpiSloc {
    static constexpr bool PRE = false;
    static constexpr bool PERM = true;
    bf16_t* C;
    __device__ __forceinline__ void operator()(const f32x4 (&acc)[2][2][4][2], const Unit& u, int wr, int wc, int fr, int fq) const {
        const int row0 = u.pm * 256 + wr * 64 + fr, col0 = wc * 32 + 8 * fq;
#pragma unroll
        for (int ai = 0; ai < 2; ++ai)
#pragma unroll
            for (int m = 0; m < 4; ++m) { bf16_t* rowp = C + (size_t)(row0 + ai * 128 + m * 16) * 256 + col0;
#pragma unroll
                for (int bj = 0; bj < 2; ++bj) { const f32x4 v0 = acc[ai][bj][m][0], v1 = acc[ai][bj][m][1];
                    u32x4 w; w.x = cvt_pk_bf16(v0[0], v0[1]); w.y = cvt_pk_bf16(v0[2], v0[3]); w.z = cvt_pk_bf16(v1[0], v1[1]); w.w = cvt_pk_bf16(v1[2], v1[3]);
                    *(u32x4*)(rowp + bj * 128) = w; } }
    }
};

struct EpiY {
    static constexpr bool PRE = false;
    static constexpr bool PERM = true;
    bf16_t* z;
    __device__ __forceinline__ void operator()(const f32x4 (&acc)[2][2][4][2], const Unit& u, int wr, int wc, int fr, int fq) const {
        const int g = u.pn, crow0 = (u.pm - 9 * g) * 256 + wr * 64 + fr;
#pragma unroll
        for (int ai = 0; ai < 2; ++ai)
#pragma unroll
            for (int m = 0; m < 4; ++m) {
                const int cr = crow0 + ai * 128 + m * 16;
                if (cr < NCH) {
#pragma unroll
                    for (int bj = 0; bj < 2; ++bj) {
                        const int ncol = 128 * bj + 32 * wc + 8 * fq, t = ncol >> 4, hh = ncol & 15;
                        constexpr float K0 = -1.5957691216057308f * LOG2E, K1 = K0 * 0.044715f;
                        const f32x2 k0v = {K0, K0}, k1v = {K1, K1}, one = {1.0f, 1.0f};
                        f32x2 o[4];
#pragma unroll
                        for (int n = 0; n < 2; ++n)
#pragma unroll
                            for (int jp = 0; jp < 2; ++jp) {
                                const f32x2 y = {acc[ai][bj][m][n][2 * jp], acc[ai][bj][m][n][2 * jp + 1]};
                                const f32x2 t = (y * y * k1v + k0v) * y; const f32x2 e = {fast_exp2(t.x), fast_exp2(t.y)}; const f32x2 d = e + one; const f32x2 rc = {fast_rcp(d.x), fast_rcp(d.y)};
                                o[n * 2 + jp] = y * rc;
                            }
                        u32x4 w; w.x = cvt_pk_bf16(o[0].x, o[0].y); w.y = cvt_pk_bf16(o[1].x, o[1].y); w.z = cvt_pk_bf16(o[2].x, o[2].y); w.w = cvt_pk_bf16(o[3].x, o[3].y);
                        *(u32x4*)(z + blk(chunk_tok_row(cr, t), g * 16 + hh, D / 64)) = w;
                    }
                }
            }
    }
};

template <class Epi, int TM> struct EpiSplit {
    static constexpr bool PRE = false;
    static constexpr bool PERM = Epi::PERM;
    Epi inner; float* part; unsigned* tick; int nsplit; volatile LAS unsigned* flag;
    __device__ __forceinline__ void operator()(const f32x4 (&acc)[2][2][4][2], const Unit& u, int wr, int wc, int fr, int fq) const {
        const int tile = TM == 1 ? u.pn : u.pm, lane = fq * 16 + fr;
        const bool holder = TM == 1 ? (wr == 0) : (wc < 2);
        const int w4 = TM == 1 ? wc : wr * 2 + wc;
        const __amdgpu_buffer_rsrc_t rs = __builtin_amdgcn_make_buffer_rsrc((void*)part, 0, 176 * 65536, 0x00020000);
        if (holder) {
            const unsigned off = (unsigned)(((tile * nsplit + u.sp) * 4 + w4) * 16384 + lane * 16);
#pragma unroll
            for (int x = 0; x < 2; ++x)
#pragma unroll
                for (int m = 0; m < 4; ++m)
#pragma unroll
                    for (int n = 0; n < 2; ++n) { const f32x4 v = TM == 1 ? acc[0][x][m][n] : acc[x][0][m][n];
                        __builtin_amdgcn_raw_buffer_store_b128(__builtin_bit_cast(u32x4, v), rs, off + (unsigned)((x * 8 + m * 2 + n) * 1024), 0, 16); }
        }
        asm volatile("s_waitcnt vmcnt(0)" ::: "memory"); __builtin_amdgcn_s_barrier(); asm volatile("" ::: "memory");
        if (wr == 0 && wc == 0 && lane == 0) { const unsigned old = __hip_atomic_fetch_add(tick + tile * 16, 1u, __ATOMIC_RELAXED, __HIP_MEMORY_SCOPE_AGENT); flag[0] = old; }
        asm volatile("s_waitcnt vmcnt(0) lgkmcnt(0)" ::: "memory"); __builtin_amdgcn_s_barrier(); asm volatile("" ::: "memory");
        const bool last = (int)(flag[0] % (unsigned)nsplit) == nsplit - 1;
        if (!last) return;
        __builtin_amdgcn_fence(__ATOMIC_ACQUIRE, "agent");
        asm volatile("s_waitcnt vmcnt(0)" ::: "memory");
        f32x4 acc2[2][2][4][2];
#pragma unroll
        for (int a = 0; a < 2; ++a)
#pragma unroll
            for (int b = 0; b < 2; ++b)
#pragma unroll
                for (int m = 0; m < 4; ++m)
#pragma unroll
                    for (int n = 0; n < 2; ++n) acc2[a][b][m][n] = (f32x4){0.f, 0.f, 0.f, 0.f};
        if (holder) {
            const float* p0 = part + (size_t)((tile * nsplit * 4 + w4) * 4096 + lane * 4);
            f32x4 va[16], vb[16];
#define ES_LOAD(dst, sp_) do { const float* p_ = p0 + (size_t)(sp_) * 16384; _Pragma("unroll") for (int i = 0; i < 16; ++i) dst[i] = *(const f32x4*)(p_ + i * 256); } while (0)
#define ES_ADD(src) do { _Pragma("unroll") for (int x = 0; x < 2; ++x) _Pragma("unroll") for (int m = 0; m < 4; ++m) _Pragma("unroll") for (int n = 0; n < 2; ++n) { \
            if (TM == 1) acc2[0][x][m][n] += src[x * 8 + m * 2 + n]; else acc2[x][0][m][n] += src[x * 8 + m * 2 + n]; } } while (0)
#pragma unroll 1
            for (int sp = 0; sp < nsplit; sp += 2) {
                asm volatile("" ::: "memory");
                const int spb = sp + 1 < nsplit ? sp + 1 : sp;
                ES_LOAD(va, sp); ES_LOAD(vb, spb);
                ES_ADD(va);
                if (sp + 1 < nsplit) ES_ADD(vb);
            }
#undef ES_LOAD
#undef ES_ADD
        }
        Unit u2 = u; u2.k0 = 0; u2.sp = 0; u2.thin = TM;
        inner(acc2, u2, wr, wc, fr, fq);
    }
};

struct Ctx { LAS unsigned char* lds; int tid, lane, wave, G, c; };
__device__ __forceinline__ Ctx fresh(const Ctx& F) { Ctx R = F; int t = threadIdx.x; asm volatile("" : "+v"(t)); R.tid = t; R.lane = t & 63; return R; }

__device__ __forceinline__ void tail_core(const bf16_t* At, int ktA, const bf16_t* W, int ktW, int rowa, int rowb, int ks0, int nks, int lane, f32x4 (&acc)[3][2]) {
    const int fr = lane & 15, fq = lane >> 4;
    const bf16_t* pa = At + ((size_t)((NREAL >> 8) * ktA) << 14) + (size_t)fr * 32 + 8 * fq;
    const bf16_t* pb0 = W + ((size_t)((rowa >> 8) * ktW) << 14) + (size_t)((rowa & 255) + fr) * 32 + 8 * fq;
    const bf16_t* pb1 = W + ((size_t)((rowb >> 8) * ktW) << 14) + (size_t)((rowb & 255) + fr) * 32 + 8 * fq;
#pragma unroll 8
    for (int ks = ks0; ks < ks0 + nks; ++ks) {
        const size_t ko = ((size_t)(ks >> 1) << 14) + (size_t)(ks & 1) * 8192;
        const bf16x8 a0 = *(const bf16x8*)(pa + ko), a1 = *(const bf16x8*)(pa + ko + 512), a2 = *(const bf16x8*)(pa + ko + 1024);
        const bf16x8 b0 = *(const bf16x8*)(pb0 + ko), b1 = *(const bf16x8*)(pb1 + ko);
        acc[0][0] = __builtin_amdgcn_mfma_f32_16x16x32_bf16(b0, a0, acc[0][0], 0, 0, 0); acc[0][1] = __builtin_amdgcn_mfma_f32_16x16x32_bf16(b1, a0, acc[0][1], 0, 0, 0);
        acc[1][0] = __builtin_amdgcn_mfma_f32_16x16x32_bf16(b0, a1, acc[1][0], 0, 0, 0); acc[1][1] = __builtin_amdgcn_mfma_f32_16x16x32_bf16(b1, a1, acc[1][1], 0, 0, 0);
        acc[2][0] = __builtin_amdgcn_mfma_f32_16x16x32_bf16(b0, a2, acc[2][0], 0, 0, 0); acc[2][1] = __builtin_amdgcn_mfma_f32_16x16x32_bf16(b1, a2, acc[2][1], 0, 0, 0);
    }
}
constexpr int TAIL_LDS_INV = 0, TAIL_LDS_PART = 1024;
__device__ __forceinline__ void tail_inv48(const Ctx& F, const float* sst, int ntp) {
    LAS float* inv48 = (LAS float*)(F.lds + TAIL_LDS_INV);
    float v[6];
#pragma unroll
    for (int i = 0; i < 6; ++i) { const int row = F.wave * 6 + i; const float a = F.lane < ntp ? sst[row * 128 + F.lane] : 0.f, b = F.lane + 64 < ntp ? sst[row * 128 + 64 + F.lane] : 0.f; v[i] = a + b; }
#pragma unroll
    for (int i = 0; i < 6; ++i) { const float t = wave_sum(v[i]); if (F.lane == 0) inv48[F.wave * 6 + i] = rsqrtf(t * (1.0f / D) + RMS_EPS); }
    __syncthreads();
}
template <int S, class Map, class Epi>
__device__ __forceinline__ void tail_gemm(const Ctx& F, const bf16_t* At, int ktA, const bf16_t* W, int ktW, int K, int ntasks, const Map& map, const Epi& epi) {
    constexpr int TPC = 8 / S;
    LAS float* part = (LAS float*)(F.lds + TAIL_LDS_PART);
    const int sub = F.wave / S, sp = F.wave - sub * S, nks = K / 32 / S;
    for (int base = F.c * TPC; base < ntasks; base += F.G * TPC) {
        const int task = base + sub; const bool valid = task < ntasks;
        f32x4 acc[3][2];
#pragma unroll
        for (int m = 0; m < 3; ++m) { acc[m][0] = (f32x4){0.f, 0.f, 0.f, 0.f}; acc[m][1] = (f32x4){0.f, 0.f, 0.f, 0.f}; }
        if (valid) { int ra, rb; map(task, ra, rb); tail_core(At, ktA, W, ktW, ra, rb, sp * nks, nks, F.lane, acc); }
        if (sp != 0) {
#pragma unroll
            for (int m = 0; m < 3; ++m)
#pragma unroll
                for (int t = 0; t < 2; ++t) *(LAS f32x4*)(part + ((F.wave * 6 + m * 2 + t) * 64 + F.lane) * 4) = acc[m][t];
        }
        __syncthreads();
        if (valid && sp == 0) {
#pragma unroll
            for (int s2 = 1; s2 < S; ++s2)
#pragma unroll
                for (int m = 0; m < 3; ++m)
#pragma unroll
                    for (int t = 0; t < 2; ++t) acc[m][t] += *(const LAS f32x4*)(part + (((F.wave + s2) * 6 + m * 2 + t) * 64 + F.lane) * 4);
            epi(task, acc, F.lane);
        }
        __syncthreads();
    }
}
struct TMapPair  { __device__ __forceinline__ void operator()(int task, int& ra, int& rb) const { const int j0 = 16 * task; ra = 256 * (j0 >> 7) + (j0 & 127); rb = ra + 128; } };
struct TMapPlain { __device__ __forceinline__ void operator()(int task, int& ra, int& rb) const { ra = 32 * task; rb = ra + 16; } };
struct TMapQK    { __device__ __forceinline__ void operator()(int task, int& ra, int& rb) const { const int head = task >> 2, i0 = 16 * (task & 3); ra = 256 * (head >> 1) + (head & 1) * 64 + i0; rb = ra + 128; } };
struct TEpiSwiGLU {
    bf16_t* act; const LAS float* inv48;
    __device__ __forceinline__ void operator()(int task, const f32x4 (&acc)[3][2], int lane) const {
        const int fr = lane & 15, fq = lane >> 4, j0 = 16 * task;
#pragma unroll
        for (int m = 0; m < 3; ++m) { const int tok = 16 * m + fr; const float inv = inv48[tok]; float o[4];
#pragma unroll
            for (int j = 0; j < 4; ++j) { const float gt = acc[m][0][j] * inv, up = acc[m][1][j] * inv; o[j] = gt * sigmoidf_(gt) * up; }
            u32x2 w; w.x = cvt_pk_bf16(o[0], o[1]); w.y = cvt_pk_bf16(o[2], o[3]);
            *(u32x2*)(act + blk(NREAL + tok, j0 + 4 * fq, DFF / 64)) = w; }
    }
};
struct TEpiResid {
    bf16_t* hb; float* sst; float scale;
    __device__ __forceinline__ void operator()(int task, const f32x4 (&acc)[3][2], int lane) const {
        const int fr = lane & 15, fq = lane >> 4;
        u32x2 hw[3][2];
#pragma unroll
        for (int m = 0; m < 3; ++m)
#pragma unroll
            for (int t = 0; t < 2; ++t) hw[m][t] = *(const u32x2*)(hb + blk(NREAL + 16 * m + fr, 32 * task + 16 * t + 4 * fq, D / 64));
#pragma unroll
        for (int m = 0; m < 3; ++m) { const int tok = 16 * m + fr; float s = 0.f;
#pragma unroll
            for (int t = 0; t < 2; ++t) { bf16_t* p = hb + blk(NREAL + tok, 32 * task + 16 * t + 4 * fq, D / 64); const u32x2 w0 = hw[m][t];
                f32x4 v; v[0] = __builtin_bit_cast(float, w0.x << 16); v[1] = __builtin_bit_cast(float, w0.x & 0xffff0000u); v[2] = __builtin_bit_cast(float, w0.y << 16); v[3] = __builtin_bit_cast(float, w0.y & 0xffff0000u);
                v += scale * acc[m][t];
                u32x2 w; w.x = cvt_pk_bf16(v[0], v[1]); w.y = cvt_pk_bf16(v[2], v[3]); *(u32x2*)p = w;
                s += (v[0] * v[0] + v[1] * v[1]) + (v[2] * v[2] + v[3] * v[3]); }
            s += __shfl_xor(s, 16); s += __shfl_xor(s, 32);
            if (fq == 0) sst[tok * 128 + task] = s; }
    }
};
struct TEpiGLU {
    bf16_t* hb; float* sst; float scale;
    __device__ __forceinline__ void operator()(int task, const f32x4 (&acc)[3][2], int lane) const {
        const int fr = lane & 15, fq = lane >> 4;
        u32x2 hw[3];
#pragma unroll
        for (int m = 0; m < 3; ++m) hw[m] = *(const u32x2*)(hb + blk(NREAL + 16 * m + fr, 16 * task + 4 * fq, D / 64));
#pragma unroll
        for (int m = 0; m < 3; ++m) { const int tok = 16 * m + fr;
            bf16_t* p = hb + blk(NREAL + tok, 16 * task + 4 * fq, D / 64); const u32x2 w0 = hw[m];
            f32x4 v; v[0] = __builtin_bit_cast(float, w0.x << 16); v[1] = __builtin_bit_cast(float, w0.x & 0xffff0000u); v[2] = __builtin_bit_cast(float, w0.y << 16); v[3] = __builtin_bit_cast(float, w0.y & 0xffff0000u);
#pragma unroll
            for (int j = 0; j < 4; ++j) v[j] += scale * acc[m][0][j] * sigmoidf_(acc[m][1][j]);
            u32x2 w; w.x = cvt_pk_bf16(v[0], v[1]); w.y = cvt_pk_bf16(v[2], v[3]); *(u32x2*)p = w;
            float s = (v[0] * v[0] + v[1] * v[1]) + (v[2] * v[2] + v[3] * v[3]);
            s += __shfl_xor(s, 16); s += __shfl_xor(s, 32);
            if (fq == 0) sst[tok * 128 + task] = s; }
    }
};
struct TEpiQK {
    bf16_t* qk; const LAS float* inv48; const float* ropec; const float* ropes; float qscale;
    __device__ __forceinline__ void operator()(int task, const f32x4 (&acc)[3][2], int lane) const {
        const int fr = lane & 15, fq = lane >> 4, head = task >> 2, i = 16 * (task & 3) + 4 * fq; const float sc = head < 16 ? qscale : 1.0f;
#pragma unroll
        for (int m = 0; m < 3; ++m) { const int tok = 16 * m + fr, pos = tok & 15; const float inv = inv48[tok] * sc;
            const f32x4 c = *(const f32x4*)(ropec + pos * 64 + i), sn = *(const f32x4*)(ropes + pos * 64 + i);
            float o1[4], o2[4];
#pragma unroll
            for (int j = 0; j < 4; ++j) { const float xa = acc[m][0][j] * inv, xb = acc[m][1][j] * inv; o1[j] = xa * c[j] - xb * sn[j]; o2[j] = xb * c[j] + xa * sn[j]; }
            bf16_t* op = qk + (size_t)(NREAL + tok) * QKLD + head * 128 + i;
            u32x2 w; w.x = cvt_pk_bf16(o1[0], o1[1]); w.y = cvt_pk_bf16(o1[2], o1[3]); *(u32x2*)op = w;
            w.x = cvt_pk_bf16(o2[0], o2[1]); w.y = cvt_pk_bf16(o2[2], o2[3]); *(u32x2*)(op + 64) = w; }
    }
};
struct TEpiVt {
    bf16_t* vt; const LAS float* inv48;
    __device__ __forceinline__ void operator()(int task, const f32x4 (&acc)[3][2], int lane) const {
        const int fr = lane & 15, fq = lane >> 4;
#pragma unroll
        for (int m = 0; m < 3; ++m) { const int tok = 16 * m + fr; const float inv = inv48[tok];
#pragma unroll
            for (int t = 0; t < 2; ++t)
#pragma unroll
                for (int j = 0; j < 4; j += 2) { const unsigned pk = cvt_pk_bf16(acc[m][t][j] * inv, acc[m][t][j + 1] * inv); bf16_t* p = vt + (size_t)(32 * task + 16 * t + 4 * fq + j) * MPAD + NREAL + tok;
                    p[0] = (bf16_t)(pk & 0xffffu); p[MPAD] = (bf16_t)(pk >> 16); } }
    }
};

__device__ __forceinline__ void transpose_item(const float* W, int K, int N, const float* gain, bf16_t* WT, int out_row0, LAS float* scr, int k0, int n0, int lane) {
    {
        const int n4 = (lane & 7) * 4, kr = lane >> 3;
        f32x4 v[8];
#pragma unroll
        for (int i = 0; i < 8; ++i) v[i] = *(const f32x4*)(W + (size_t)(k0 + kr + 8 * i) * N + n0 + n4);
#pragma unroll
        for (int i = 0; i < 8; ++i) { const int kk = kr + 8 * i; const float gk = gain ? gain[k0 + kk] : 1.0f; LAS float* d = scr + kk * 33 + n4;
            d[0] = v[i][0] * gk; d[1] = v[i][1] * gk; d[2] = v[i][2] * gk; d[3] = v[i][3] * gk; }
    }
    asm volatile("s_waitcnt lgkmcnt(0)" ::: "memory");
    const int c = lane & 7;
#pragma unroll
    for (int j = 0; j < 4; ++j) { const int n = (lane >> 3) + 8 * j; const LAS float* s = scr + (8 * c) * 33 + n;
        u32x4 o; o.x = cvt_pk_bf16(s[0 * 33], s[1 * 33]); o.y = cvt_pk_bf16(s[2 * 33], s[3 * 33]); o.z = cvt_pk_bf16(s[4 * 33], s[5 * 33]); o.w = cvt_pk_bf16(s[6 * 33], s[7 * 33]);
        *(u32x4*)(WT + blk(out_row0 + n, k0 + 8 * c, K >> 6)) = o; }
    asm volatile("s_waitcnt lgkmcnt(0)" ::: "memory");
}
__device__ __forceinline__ void transpose_matrix(const Ctx& F, const float* W, int K, int N, const float* gain, bf16_t* WT, bf16_t* WT2, int kind, int s0, int s1, int NS, int wave_lo) {
    if (F.wave < wave_lo) return;
    LAS float* scr = (LAS float*)(F.lds + F.wave * 16384);
    const int nblk = N / 32, nitems = (K / 64) * nblk;
    const int lo = (int)((long)nitems * s0 / NS), hi = (int)((long)nitems * s1 / NS);
    const int gw = (F.wave - wave_lo) * F.G + F.c, NGW = F.G * (8 - wave_lo);
    for (int it = lo + gw; it < hi; it += NGW) {
        const int kb = it / nblk, nb = it - kb * nblk, k0 = 64 * kb, n0 = 32 * nb;
        bf16_t* dst = WT; int row0;
        if (kind == 0) row0 = n0;
        else if (kind == 1) row0 = 256 * (n0 >> 7) + (n0 & 127);
        else if (kind == 2) row0 = 256 * (n0 >> 7) + 128 + (n0 & 127);
        else { if (n0 < 2560) { const int head = n0 >> 7, i0 = n0 & 127; row0 = 256 * (head >> 1) + ((i0 >= 64) ? 128 : 0) + (head & 1) * 64 + (i0 & 63); } else { dst = WT2; row0 = n0 - 2560; } }
        transpose_item(W, K, N, gain, dst, row0, scr, k0, n0, F.lane);
    }
}

__device__ __forceinline__ void phase_init(const Ctx& F, const float* xp, const float* xs, const float* meta, bf16_t* hb, float* ss, float* sst, float* ropec, float* ropes,
                                           const float* a_re, const float* a_im, const float* log_dt, const float* b_re, const float* b_im, float* s5t) {
    const int gw = F.c * 8 + F.wave, NGW = F.G * 8;
    for (int r = gw; r < MPAD; r += NGW) {
        const float* src = r < 16384 ? xp + (size_t)r * D : (r < NREAL ? xs + (size_t)(r - 16384) * D : (r < MVALID ? meta + (size_t)((r - NREAL) & 15) * D : nullptr));
        float part[8]; f32x4 xv[8];
#pragma unroll
        for (int j = 0; j < 8; ++j) xv[j] = src ? *(const f32x4*)(src + 256 * j + 4 * F.lane) : (f32x4){0.f, 0.f, 0.f, 0.f};
#pragma unroll
        for (int j = 0; j < 8; ++j) {
            const f32x4 v = xv[j];
            u32x2 w; w.x = cvt_pk_bf16(v[0], v[1]); w.y = cvt_pk_bf16(v[2], v[3]);
            *(u32x2*)(hb + blk(r, 256 * j + 4 * F.lane, D / 64)) = w;
            part[j] = wave_sum((v[0] * v[0] + v[1] * v[1]) + (v[2] * v[2] + v[3] * v[3]));
        }
        if (F.lane < 16) { float v = 0.f;
#pragma unroll
            for (int j = 0; j < 8; ++j) v = (F.lane == j) ? part[j] : v;
            ss[(size_t)r * 16 + F.lane] = v; }
        if (r >= NREAL && r < MVALID) { const float tot = ((part[0] + part[1]) + (part[2] + part[3])) + ((part[4] + part[5]) + (part[6] + part[7]));
            sst[(r - NREAL) * 128 + F.lane] = F.lane == 0 ? tot : 0.f; sst[(r - NREAL) * 128 + 64 + F.lane] = 0.f; }
    }
    {
        const int gw2 = F.c * 8 + F.wave, NGW2 = F.G * 8, i = F.lane;
        const double invf = exp2(-(double)i * (13.287712379549449 / 64.0));
        const double cd = cos(invf), sd = sin(invf);
        for (int pb = gw2; pb * 16 < 16400; pb += NGW2) {
            const int pos0 = pb * 16; const double a0 = (double)pos0 * invf;
            double c = cos(a0), sn = sin(a0);
            for (int k = 0; k < 16 && pos0 + k < 16400; ++k) {
                const int e = (pos0 + k) * 64 + i;
                ropec[e] = (float)c; ropes[e] = (float)sn;
                const double c2 = c * cd - sn * sd, s2 = sn * cd + c * sd; c = c2; sn = s2;
            }
        }
    }
    {
        const int gt = F.c * 512 + F.tid, NGT = F.G * 512;
        for (int e4 = gt; e4 < 4 * 2 * NG * 2 * 64; e4 += NGT) {
            if (e4 & 3) continue;
            const int idx = e4 >> 2;
            const int p = idx & 63, dir = (idx >> 6) & 1, g = (idx >> 7) & 127, layer = idx >> 14;
            const size_t pi = ((size_t)(layer * 2 + dir) * NG + g) * 64 + p;
            const double are = a_re[pi], aim = a_im[pi], dt = exp((double)log_dt[(layer * 2 + dir) * NG + g]);
            const double mag = exp(are * dt), ang = aim * dt;
            const double ar = mag * cos(ang), ai = mag * sin(ang);
            double zr = 1.0, zi = 0.0;
            for (int q = 0; q < 17; ++q) {
                s5t[((size_t)idx * 17 + q) * 2] = (float)zr; s5t[((size_t)idx * 17 + q) * 2 + 1] = (float)zi;
                const double tr = zr * ar - zi * ai, ti = zr * ai + zi * ar; zr = tr; zi = ti;
            }
            const double nr = ar - 1.0, ni = ai;
            const double den = are * are + aim * aim;
            const double fr_ = (nr * are + ni * aim) / den, fi_ = (ni * are - nr * aim) / den;
            for (int hq = 0; hq < 16; ++hq) {
                const double br = b_re[pi * 16 + hq], bim = b_im[pi * 16 + hq];
                s5t[S5T_BB_OFF + ((size_t)idx * 16 + hq) * 2] = (float)(fr_ * br - fi_ * bim); s5t[S5T_BB_OFF + ((size_t)idx * 16 + hq) * 2 + 1] = (float)(fr_ * bim + fi_ * br);
            }
        }
    }
}

__device__ __forceinline__ void phase_final(const Ctx& F, const bf16_t* hb, const float* ss, int nparts, const float* fn, float* out) {
    const int gw = F.c * 8 + F.wave, NGW = F.G * 8;
    for (int r = gw; r < NREAL; r += NGW) {
        const float inv = row_inv(ss, r, nparts);
        u32x4 hv[4];
#pragma unroll
        for (int j = 0; j < 4; ++j) hv[j] = *(const u32x4*)(hb + blk(r, 512 * j + 8 * F.lane, D / 64));
#pragma unroll
        for (int j = 0; j < 4; ++j) {
            const int c0 = 512 * j + 8 * F.lane;
            f32x4 v0, v1; unpack8(hv[j], v0, v1);
            const f32x4 g0 = *(const f32x4*)(fn + c0), g1 = *(const f32x4*)(fn + c0 + 4);
            *(f32x4*)(out + (size_t)r * D + c0) = v0 * inv * g0; *(f32x4*)(out + (size_t)r * D + c0 + 4) = v1 * inv * g1;
        }
    }
}

__device__ __forceinline__ void s5_build_group(const Ctx& F, int g, int half, const float* pwt, const float* bbt,
                                               const float* c_re, const float* c_im, const float* dvec, const float* gain, bf16_t* BmatT, bf16_t* WyT, float* A16) {
    LAS float* pw = (LAS float*)F.lds; LAS float* bb = pw + 4352; LAS float* cc = bb + 4096; LAS float* Kt = cc + 4096; LAS float* gn = Kt + 8192; LAS float* dd = gn + 16;
    const int tid = F.tid;
    __syncthreads();
    for (int e = tid; e < 2 * 64 * 17 * 2; e += 512) pw[e] = pwt[(size_t)g * (2 * 64 * 17 * 2) + e];
    for (int e = tid; e < 2 * 64 * 16 * 2; e += 512) bb[e] = bbt[(size_t)g * (2 * 64 * 16 * 2) + e];
    for (int e = tid; e < 2 * 16 * 64; e += 512) {
        const int dir = e >> 10, hh = (e >> 6) & 15, pp = e & 63;
        const size_t ci = ((size_t)((dir * NG + g) * 16 + hh)) * 64 + pp;
        cc[e * 2] = c_re[ci]; cc[e * 2 + 1] = c_im[ci];
    }
    if (tid < 16) { gn[tid] = gain[g * 16 + tid]; dd[tid] = dvec[g * 16 + tid]; }
    __syncthreads();
    {
        const int dir = tid >> 8, hh = (tid >> 4) & 15, hq = half * 8 + (tid & 7), tau0 = ((tid >> 3) & 1) * 8;
        float sacc[8];
#pragma unroll
        for (int k = 0; k < 8; ++k) sacc[k] = 0.f;
        for (int p = 0; p < 64; ++p) {
            const float cr = cc[((dir * 16 + hh) * 64 + p) * 2], ci = cc[((dir * 16 + hh) * 64 + p) * 2 + 1];
            const float br = bb[((dir * 64 + p) * 16 + hq) * 2], bi = bb[((dir * 64 + p) * 16 + hq) * 2 + 1];
            const float wr_ = cr * br - ci * bi, wi_ = cr * bi + ci * br;
#pragma unroll
            for (int k = 0; k < 8; ++k) { const float pr = pw[((dir * 64 + p) * 17 + tau0 + k) * 2], pi = pw[((dir * 64 + p) * 17 + tau0 + k) * 2 + 1]; sacc[k] += wr_ * pr - wi_ * pi; }
        }
#pragma unroll
        for (int k = 0; k < 8; ++k) Kt[(dir * 16 + tau0 + k) * 256 + hh * 16 + hq] = sacc[k];
    }
    __syncthreads();
    bf16_t* Bg = BmatT + (size_t)g * 256 * 256; bf16_t* Wg = WyT + (size_t)g * 256 * 512;
    for (int q2 = tid; q2 < 256 * 16; q2 += 512) { const int q = 2 * q2 + half;
        const int n = q >> 5, k0 = (q & 31) * 8, t = n >> 4, hh = n & 15, j = k0 >> 4, h0 = k0 & 15;
        float o[8];
#pragma unroll
        for (int e = 0; e < 8; ++e) {
            const int hq = h0 + e; float v = 0.f;
            if (j <= t) v += Kt[(0 * 16 + (t - j)) * 256 + hh * 16 + hq];
            if (j >= t) v += Kt[(1 * 16 + (j - t)) * 256 + hh * 16 + hq];
            if (j == t && hq == hh) v += dd[hh];
            o[e] = v * gn[hq];
        }
        u32x4 w; w.x = cvt_pk_bf16(o[0], o[1]); w.y = cvt_pk_bf16(o[2], o[3]); w.z = cvt_pk_bf16(o[4], o[5]); w.w = cvt_pk_bf16(o[6], o[7]);
        *(u32x4*)(Wg + blk(n, k0, 8)) = w;
    }
    for (int q2 = tid; q2 < 256 * 16; q2 += 512) { const int q = 2 * q2 + half;
        const int n = q >> 5, r0 = (q & 31) * 8, t = n >> 4, hh = n & 15, dir = r0 >> 7, part = (r0 >> 6) & 1, p0 = r0 & 63;
        const int ex = dir == 0 ? t + 1 : 16 - t;
        float o[8];
#pragma unroll
        for (int e = 0; e < 8; ++e) {
            const int p = p0 + e;
            const float cr = cc[((dir * 16 + hh) * 64 + p) * 2], ci = cc[((dir * 16 + hh) * 64 + p) * 2 + 1];
            const float pr = pw[((dir * 64 + p) * 17 + ex) * 2], pi = pw[((dir * 64 + p) * 17 + ex) * 2 + 1];
            o[e] = part == 0 ? (cr * pr - ci * pi) : -(cr * pi + ci * pr);
        }
        u32x4 w; w.x = cvt_pk_bf16(o[0], o[1]); w.y = cvt_pk_bf16(o[2], o[3]); w.z = cvt_pk_bf16(o[4], o[5]); w.w = cvt_pk_bf16(o[6], o[7]);
        *(u32x4*)(Wg + blk(n, 256 + r0, 8)) = w;
    }
    for (int q2 = tid; q2 < 256 * 16; q2 += 512) { const int q = 2 * q2 + half;
        const int col = q >> 5, k0 = (q & 31) * 8, dir = col >> 7, part = col & 1, p = (col >> 1) & 63, j = k0 >> 4, h0 = k0 & 15;
        const int ex = dir == 0 ? 15 - j : j;
        const float pr = pw[((dir * 64 + p) * 17 + ex) * 2], pi = pw[((dir * 64 + p) * 17 + ex) * 2 + 1];
        float o[8];
#pragma unroll
        for (int e = 0; e < 8; ++e) {
            const int hq = h0 + e;
            const float br = bb[((dir * 64 + p) * 16 + hq) * 2], bi = bb[((dir * 64 + p) * 16 + hq) * 2 + 1];
            o[e] = (part == 0 ? (pr * br - pi * bi) : (pr * bi + pi * br)) * gn[hq];
        }
        u32x4 w; w.x = cvt_pk_bf16(o[0], o[1]); w.y = cvt_pk_bf16(o[2], o[3]); w.z = cvt_pk_bf16(o[4], o[5]); w.w = cvt_pk_bf16(o[6], o[7]);
        *(u32x4*)(Bg + blk(col, k0, 4)) = w;
    }
    if (half == 0 && tid < 128) { const int dir = tid >> 6, p = tid & 63; A16[((g * 2 + dir) * 64 + p) * 2] = pw[((dir * 64 + p) * 17 + 16) * 2]; A16[((g * 2 + dir) * 64 + p) * 2 + 1] = pw[((dir * 64 + p) * 17 + 16) * 2 + 1]; }
    __syncthreads();
}

__device__ __forceinline__ void phase_s5a(const Ctx& F, const bf16_t* hb, const float* ss, int nparts, const float* sst, int ntp, bf16_t* XS) {
    LAS bf16_t* buf = (LAS bf16_t*)F.lds;
    u32x4 cv[2][4], nv[2][4]; float cinv[2], ninv[2];
#define S5A_LOAD(dv, dinv, cr_) do { _Pragma("unroll") for (int q = 0; q < 2; ++q) { const int t = F.wave * 2 + q, r = chunk_tok_row((cr_), t); \
        if (TAIL_DIRECT && r >= NREAL) { const float* p = sst + (r - NREAL) * 128; float v = F.lane < ntp ? p[F.lane] : 0.f; if (F.lane + 64 < ntp) v += p[64 + F.lane]; dinv[q] = rsqrtf(wave_sum(v) * (1.0f / D) + RMS_EPS); } \
        else dinv[q] = row_inv(ss, r, nparts); \
        _Pragma("unroll") for (int j = 0; j < 4; ++j) dv[q][j] = *(const u32x4*)(hb + blk(r, 512 * j + 8 * F.lane, D / 64)); } } while (0)
#define S5A_CHUNK(k_) (F.G != 256 ? F.c + (k_) * F.G : ((k_) < 8 ? 2 * (F.c + 256 * ((k_) >> 1)) + ((k_) & 1) : 2048 + F.c + ((k_) - 8) * 256))
    int kk = 0, cr = S5A_CHUNK(0);
    if (cr < NCH) S5A_LOAD(cv, cinv, cr);
    for (; cr < NCH; ) {
        const int crn = S5A_CHUNK(kk + 1); ++kk;
        __syncthreads();
#pragma unroll
        for (int q = 0; q < 2; ++q) {
            const int t = F.wave * 2 + q;
#pragma unroll
            for (int j = 0; j < 4; ++j) {
                f32x4 v0, v1; unpack8(cv[q][j], v0, v1);
                v0 *= cinv[q]; v1 *= cinv[q];
                u32x4 w; w.x = cvt_pk_bf16(v0[0], v0[1]); w.y = cvt_pk_bf16(v0[2], v0[3]); w.z = cvt_pk_bf16(v1[0], v1[1]); w.w = cvt_pk_bf16(v1[2], v1[3]);
                *(LAS u32x4*)(buf + t * 2048 + 512 * j + 8 * F.lane) = w;
            }
        }
        if (crn < NCH) S5A_LOAD(nv, ninv, crn);
        __syncthreads();
#pragma unroll
        for (int i = 0; i < 8; ++i) {
            const int q = F.tid + 512 * i, g = q >> 5, t = (q >> 1) & 15, half = q & 1;
            const u32x4 w = *(const LAS u32x4*)(buf + t * 2048 + g * 16 + half * 8);
            *(u32x4*)(XS + blk(g * NCHP + cr, t * 16 + half * 8, 8)) = w;
        }
#pragma unroll
        for (int q = 0; q < 2; ++q) { cinv[q] = ninv[q];
#pragma unroll
            for (int j = 0; j < 4; ++j) cv[q][j] = nv[q][j]; }
        cr = crn;
    }
#undef S5A_CHUNK
#undef S5A_LOAD
    __syncthreads();
}

__device__ __forceinline__ void phase_scan(const Ctx& F, const unsigned* Sloc, bf16_t* XS, const float* A16) {
    LAS float* carry = (LAS float*)F.lds;
    const int p = F.lane, w = F.wave;
#pragma unroll 1
    for (int task = F.c; task < 768; task += F.G) {
        const int so = task >> 8, g = F.G == 256 ? 16 * (F.c & 7) + (F.c >> 4) : (task >> 1) & 127, dir = F.G == 256 ? (F.c >> 3) & 1 : task & 1;
        const int s = so == 0 ? 2 : so - 1;
        const int crb = s == 2 ? 1026 : (s == 1 ? 513 : 0), n = s == 2 ? 1025 : 513, L = s == 2 ? 129 : 65, nsq = s == 2 ? 7 : 6;
        const int cb = w * L, ce = (cb + L) < n ? (cb + L) : n;
        const float ar = A16[((g * 2 + dir) * 64 + p) * 2], ai = A16[((g * 2 + dir) * 64 + p) * 2 + 1];
        const char* srcg = (const char*)(Sloc + (size_t)g * NCHP * 128);
        char* xsg = (char*)(XS + (size_t)g * ((NCHP / 256) * 8 * 16384));
        const unsigned lane_l = (unsigned)(dir * 64 + p) * 4u;
        const unsigned colre = 256u + (unsigned)dir * 128u + (unsigned)p;
        const unsigned lane_re = (((colre >> 6) << 14) + (((colre >> 5) & 1u) << 13) + (colre & 31u)) * 2u, lane_im = lane_re + 32768u;
        float sr = 0.f, si = 0.f;
        float lr[8], li[8], nr_[8], ni_[8];
#define SCAN_ROW(c_) ((unsigned)(crb + (dir ? n - 1 - (c_) : (c_))))
#define SCAN_LOAD(dr, di, c0_) do { _Pragma("unroll") for (int k = 0; k < 8; ++k) { int c = (c0_) + k; c = c < ce ? c : ce - 1; const unsigned w_ = *(const unsigned*)(srcg + (SCAN_ROW(c) * 512u + lane_l)); dr[k] = __builtin_bit_cast(float, w_ << 16); di[k] = __builtin_bit_cast(float, w_ & 0xffff0000u); } } while (0)
#define SCAN_ACC(dr, di, c0_) do { _Pragma("unroll") for (int k = 0; k < 8; ++k) { const int c = (c0_) + k; if (c < ce) { \
        const float tr = ar * sr - ai * si + dr[k], ti = ar * si + ai * sr + di[k]; sr = tr; si = ti; } } } while (0)
#define SCAN_STEP(dr, di, c0_) do { _Pragma("unroll") for (int k = 0; k < 8; ++k) { const int c = (c0_) + k; if (c < ce) { const unsigned rl_ = SCAN_ROW(c), ro_ = ((rl_ >> 8) << 18) + ((rl_ & 255u) << 6); \
        const unsigned pk = cvt_pk_bf16(sr, si); *(bf16_t*)(xsg + (ro_ + lane_re)) = (bf16_t)(pk & 0xffffu); *(bf16_t*)(xsg + (ro_ + lane_im)) = (bf16_t)(pk >> 16); \
        const float tr = ar * sr - ai * si + dr[k], ti = ar * si + ai * sr + di[k]; sr = tr; si = ti; } } } while (0)
        SCAN_LOAD(lr, li, cb);
#pragma unroll 1
        for (int c0 = cb; c0 < ce; c0 += 16) {
            SCAN_LOAD(nr_, ni_, c0 + 8);
            SCAN_ACC(lr, li, c0);
            SCAN_LOAD(lr, li, c0 + 16);
            SCAN_ACC(nr_, ni_, c0 + 8);
        }
        carry[(w * 64 + p) * 2] = sr; carry[(w * 64 + p) * 2 + 1] = si;
        float qr = ar, qi = ai;
#pragma unroll 1
        for (int k = 0; k < nsq; ++k) { const float tr = qr * qr - qi * qi, ti = 2.0f * qr * qi; qr = tr; qi = ti; }
        { const float tr = qr * ar - qi * ai, ti = qr * ai + qi * ar; qr = tr; qi = ti; }
        SCAN_LOAD(lr, li, cb);
        __syncthreads();
        sr = 0.f; si = 0.f;
#pragma unroll 1
        for (int j = 0; j < w; ++j) { const float pr = carry[(j * 64 + p) * 2], pi = carry[(j * 64 + p) * 2 + 1]; const float tr = qr * sr - qi * si + pr, ti = qr * si + qi * sr + pi; sr = tr; si = ti; }
#pragma unroll 1
        for (int c0 = cb; c0 < ce; c0 += 16) {
            SCAN_LOAD(nr_, ni_, c0 + 8);
            SCAN_STEP(lr, li, c0);
            SCAN_LOAD(lr, li, c0 + 16);
            SCAN_STEP(nr_, ni_, c0 + 8);
        }
        __syncthreads();
#undef SCAN_ROW
#undef SCAN_LOAD
#undef SCAN_ACC
#undef SCAN_STEP
    }
}

__device__ __forceinline__ void phase_attn(const Ctx& F, const bf16_t* QK, const bf16_t* Vt, bf16_t* O, const float* sink) {
    const int lane = F.lane, r = lane & 31, hh = lane >> 5, wave = F.wave, tid = F.tid;
    constexpr int KROW = 272, VROW = 72, KBYTES = 32 * KROW, STAGE = KBYTES + 128 * VROW;
    const int lk_key = tid >> 4, lk_ch = tid & 15, lv_d = tid >> 2, lv_kc = tid & 3;
    for (int unit = F.c; unit < 2048 + 12; unit += F.G) {
        int s, kh, qrow, head, pq, ktlo, kthi, wlo, whi; bool active = true;
        if (unit < 2048) {
            int um = unit;
            if (F.G == 256) { const int li = (unit >> 8) * 32 + (F.c >> 3); um = (((F.c & 7) * 64 + (li >> 2)) << 2) | (li & 3); }
            const int qb = um >> 2; kh = um & 3; head = kh * 4 + (wave >> 1);
            const int q0 = qb * 64; s = q0 >= 16384 ? 2 : (q0 >= 8192 ? 1 : 0);
            const int rb = s == 2 ? 16384 : s * 8192, S = s == 2 ? 16384 : 8192, q0rel = q0 - rb, qrel = q0rel + (wave & 1) * 32;
            qrow = q0 + (wave & 1) * 32 + r; pq = qrel + r + 16;
            int lo = q0rel - 128; lo = lo < 0 ? 0 : lo; int hi = q0rel + 192; hi = hi > S ? S : hi; ktlo = lo >> 5; kthi = hi >> 5;
            lo = qrel - 128; lo = lo < 0 ? 0 : lo; hi = qrel + 160; hi = hi > S ? S : hi; wlo = lo >> 5; whi = hi >> 5;
        } else {
            const int mu = unit - 2048; s = mu >> 2; kh = mu & 3; active = wave < 2;
            head = kh * 4 + (wave & 1) * 2 + (r >> 4); qrow = NREAL + 16 * s + (r & 15); pq = r & 15; ktlo = 0; kthi = 4; wlo = 0; whi = 4;
        }
        const int rb = s == 2 ? 16384 : s * 8192, ntiles = 1 + kthi - ktlo;
        bf16x8 qf[8];
#pragma unroll
        for (int ks = 0; ks < 8; ++ks) qf[ks] = *(const bf16x8*)(QK + (size_t)qrow * QKLD + head * 128 + 16 * ks + 8 * hh);
        f32x16 o[4];
#pragma unroll
        for (int db = 0; db < 4; ++db)
#pragma unroll
            for (int e = 0; e < 16; ++e) o[db][e] = 0.f;
        float mrun = sink[head] * LOG2E, lrun = 1.0f;
        u32x4 kreg, vreg;
        { const int krow0 = NREAL + 16 * s;
          kreg = *(const u32x4*)(QK + (size_t)(krow0 + (lk_key & 15)) * QKLD + 2048 + kh * 128 + lk_ch * 8);
          vreg = *(const u32x4*)(Vt + (size_t)(kh * 128 + lv_d) * MPAD + krow0 + lv_kc * 8); }
        const int qrel_s = unit < 2048 ? __builtin_amdgcn_readfirstlane(pq - r - 16) : (1 << 28);
        for (int t = 0; t < ntiles; ++t) {
            LAS unsigned char* st = F.lds + (t & 1) * STAGE;
            *(LAS u32x4*)(st + lk_key * KROW + lk_ch * 16) = kreg;
            { LAS unsigned char* vp = st + KBYTES + lv_d * VROW + lv_kc * 16; *(LAS u32x2*)(vp) = (u32x2){vreg.x, vreg.y}; *(LAS u32x2*)(vp + 8) = (u32x2){vreg.z, vreg.w}; }
            if (t + 1 < ntiles) { const int krow0 = rb + (ktlo + t) * 32;
                kreg = *(const u32x4*)(QK + (size_t)(krow0 + lk_key) * QKLD + 2048 + kh * 128 + lk_ch * 8);
                vreg = *(const u32x4*)(Vt + (size_t)(kh * 128 + lv_d) * MPAD + krow0 + lv_kc * 8); }
            asm volatile("s_waitcnt lgkmcnt(0)" ::: "memory"); __builtin_amdgcn_s_barrier(); asm volatile("" ::: "memory");
            const bool ismeta = t == 0; const int kt = ktlo + t - 1;
            if (active && (ismeta || (kt >= wlo && kt < whi))) {
                f32x16 sc, sc2;
#pragma unroll
                for (int e = 0; e < 16; ++e) { sc[e] = 0.f; sc2[e] = 0.f; }
#pragma unroll
                for (int ks = 0; ks < 8; ks += 2) {
                    const bf16x8 kf = *(const LAS bf16x8*)(st + r * KROW + 32 * ks + 16 * hh), kg = *(const LAS bf16x8*)(st + r * KROW + 32 * (ks + 1) + 16 * hh);
                    sc = __builtin_amdgcn_mfma_f32_32x32x16_bf16(kf, qf[ks], sc, 0, 0, 0);
                    sc2 = __builtin_amdgcn_mfma_f32_32x32x16_bf16(kg, qf[ks + 1], sc2, 0, 0, 0);
                }
#pragma unroll
                for (int e = 0; e < 16; ++e) sc[e] += sc2[e];
                float mx = -INFINITY;
                const int d0_ = qrel_s - kt * 32;
                if (!ismeta && d0_ >= -97 && d0_ <= 97) {
#pragma unroll
                    for (int e = 0; e < 16; ++e) mx = fmaxf(mx, sc[e]);
                } else {
#pragma unroll
                for (int e = 0; e < 16; ++e) {
                    const int kl = (e & 3) + 8 * (e >> 2) + 4 * hh;
                    bool ok;
                    if (ismeta) ok = kl < 16; else { const int dlt = pq - (kt * 32 + kl + 16); ok = (dlt <= 128) && (dlt >= -128); }
                    sc[e] = ok ? sc[e] : -INFINITY; mx = fmaxf(mx, sc[e]);
                }
                }
                mx = fmaxf(mx, __shfl_xor(mx, 32));
                const float mnew = fmaxf(mrun, mx), alpha = fast_exp2(mrun - mnew);
                float psum = 0.f;
#pragma unroll
                for (int e = 0; e < 16; ++e) { sc[e] = fast_exp2(sc[e] - mnew); psum += sc[e]; }
                psum += __shfl_xor(psum, 32);
                lrun = lrun * alpha + psum; mrun = mnew;
                if (!__all(alpha == 1.0f)) {
#pragma unroll
                    for (int db = 0; db < 4; ++db)
#pragma unroll
                        for (int e = 0; e < 16; ++e) o[db][e] *= alpha;
                }
                bf16x8 pf[2];
#pragma unroll
                for (int sx = 0; sx < 2; ++sx) {
                    u32x4 w; w.x = cvt_pk_bf16(sc[8 * sx + 0], sc[8 * sx + 1]); w.y = cvt_pk_bf16(sc[8 * sx + 2], sc[8 * sx + 3]); w.z = cvt_pk_bf16(sc[8 * sx + 4], sc[8 * sx + 5]); w.w = cvt_pk_bf16(sc[8 * sx + 6], sc[8 * sx + 7]);
                    pf[sx] = __builtin_bit_cast(bf16x8, w);
                }
#pragma unroll
                for (int sx = 0; sx < 2; ++sx) {
                    if (ismeta && sx == 1) continue;
#pragma unroll
                    for (int db = 0; db < 4; ++db) {
                        const LAS unsigned char* vp = st + KBYTES + (32 * db + r) * VROW + 32 * sx + 8 * hh;
                        const u32x2 lo2 = *(const LAS u32x2*)(vp), hi2 = *(const LAS u32x2*)(vp + 16);
                        u32x4 w; w.x = lo2.x; w.y = lo2.y; w.z = hi2.x; w.w = hi2.y;
                        o[db] = __builtin_amdgcn_mfma_f32_32x32x16_bf16(__builtin_bit_cast(bf16x8, w), pf[sx], o[db], 0, 0, 0);
                    }
                }
            }
        }
        if (active) {
            const float il = 1.0f / lrun;
#pragma unroll
            for (int db = 0; db < 4; ++db)
#pragma unroll
                for (int eq = 0; eq < 4; ++eq) {
                    u32x2 w; w.x = cvt_pk_bf16(o[db][4 * eq + 0] * il, o[db][4 * eq + 1] * il); w.y = cvt_pk_bf16(o[db][4 * eq + 2] * il, o[db][4 * eq + 3] * il);
                    *(u32x2*)(O + blk(qrow, head * 128 + 32 * db + 8 * eq + 4 * hh, D / 64)) = w;
                }
        }
        asm volatile("s_waitcnt lgkmcnt(0)" ::: "memory"); __builtin_amdgcn_s_barrier(); asm volatile("" ::: "memory");
    }
}

__device__ __forceinline__ void zero_pad_rows(const Ctx& F, bf16_t* buf) {
    const int gt = F.c * 512 + F.tid, NGT = F.G * 512;
    unsigned z = 0u; asm volatile("" : "+v"(z));
    constexpr int PER_KH = (MPAD - MVALID) * 32 / 8;
    for (int e = gt; e < PER_KH * 2 * (D / 64); e += NGT) { const int kh2 = e / PER_KH, q = e - kh2 * PER_KH;
        *(u32x4*)(buf + ((size_t)((MVALID >> 8) * (D / 64)) << 14) + (size_t)kh2 * 8192 + (size_t)(MVALID & 255) * 32 + (size_t)q * 8) = (u32x4){z, z, z, z}; }
}

template <class KA>
__device__ __forceinline__ void prep_layer(const Ctx& Fp, KA ka, int layer, int s0, int s1, int NS, int wave_lo) {
    unsigned char* wb = ka->ws + ((layer & 1) ? WS_W1 : WS_W);
    const int jm = layer >> 1; const bool is_s5 = (layer & 1) == 0;
    if (is_s5) {
        for (int it = 2 * NG * s0 / NS + Fp.c; it < 2 * NG * s1 / NS; it += Fp.G)
            s5_build_group(Fp, it % NG, it / NG, (const float*)(ka->ws + WS_S5T) + (size_t)jm * S5T_PW_L, (const float*)(ka->ws + WS_S5T) + S5T_BB_OFF + (size_t)jm * S5T_BB_L,
                           ka->in[13] + (size_t)jm * 2 * NG * 16 * 64, ka->in[14] + (size_t)jm * 2 * NG * 16 * 64,
                           ka->in[15] + (size_t)jm * D, ka->in[3] + (size_t)(layer * 3 + 1) * D, (bf16_t*)(wb + OW_WMIX + MIX_BMAT), (bf16_t*)(wb + OW_WMIX + MIX_WY), (float*)(ka->ws + WS_A16));
        __syncthreads();
    }
    for (int mi = 0; mi < 8; ++mi) {
        const float* W; int K, N, kind; const float* gain = nullptr; bf16_t* WT; bf16_t* WT2 = nullptr;
        if (mi < 2) {
            if (is_s5) { W = ka->in[16] + (size_t)(jm * 2 + mi) * D * D; K = D; N = D; WT = (bf16_t*)(wb + OW_WMIX + MIX_WGLU); kind = 1 + mi; }
            else if (mi == 0) { W = ka->in[17] + (size_t)jm * D * 3072; K = D; N = 3072; gain = ka->in[3] + (size_t)(layer * 3 + 1) * D; WT = (bf16_t*)(wb + OW_WMIX + MIX_WQK); WT2 = (bf16_t*)(wb + OW_WMIX + MIX_WVT); kind = 3; }
            else { W = ka->in[18] + (size_t)jm * D * D; K = D; N = D; WT = (bf16_t*)(wb + OW_WMIX + MIX_WO); kind = 0; }
        } else {
            const int hf = (mi - 2) / 3, wm = (mi - 2) - 3 * hf; const size_t wi = (size_t)(layer * 2 + hf);
            if (wm < 2) { W = ka->in[5 + wm] + wi * D * DFF; K = D; N = DFF; gain = ka->in[3] + (size_t)(layer * 3 + 2 * hf) * D; WT = (bf16_t*)(wb + (hf ? OW_WGU_B : OW_WGU_A)); kind = 1 + wm; }
            else { W = ka->in[7] + wi * DFF * D; K = DFF; N = D; WT = (bf16_t*)(wb + (hf ? OW_WD_B : OW_WD_A)); kind = 0; }
        }
        transpose_matrix(Fp, W, K, N, gain, WT, WT2, kind, s0, s1, NS, wave_lo);
    }
}

struct Args { const float* in[20]; float* out; unsigned char* ws; int ph_lo, ph_hi, li, pad; };
constexpr int PH_FINAL = 41, PH_END = 42;

typedef const __attribute__((address_space(4))) Args* KArgs;
__device__ __forceinline__ KArgs kargs() { KArgs p = (KArgs)__builtin_amdgcn_kernarg_segment_ptr(); asm volatile("" : "+s"(p)); return p; }

__global__ void __launch_bounds__(512, 2) fwd_kernel(Args args) {
    extern __shared__ __attribute__((aligned(16))) unsigned char lds_raw[];
    Ctx F; F.lds = (LAS unsigned char*)lds_raw; F.tid = threadIdx.x; F.lane = F.tid & 63; F.wave = __builtin_amdgcn_readfirstlane(F.tid >> 6); F.G = gridDim.x; F.c = blockIdx.x;
    volatile LAS unsigned* MISC = (volatile LAS unsigned*)(F.lds + MISC_OFF);
    if (F.tid < 64) MISC[F.tid] = 0u;
    __syncthreads();
    XcdBarrier bar = xcd_barrier_post((unsigned*)(args.ws + WS_CTL) + 4096 + args.li * XCD_BAR_WORDS, MISC + 8);
    const int lo = args.ph_lo, hi = args.ph_hi;
#if TIMING
    if (F.c == 0 && threadIdx.x == 0) { volatile LAS unsigned* T_ = (volatile LAS unsigned*)(F.lds + MISC_OFF + 256); const unsigned long long t_ = __builtin_amdgcn_s_memrealtime(); T_[0] = (unsigned)t_; T_[1] = (unsigned)(t_ >> 32); for (int k = 0; k < 16; ++k) T_[2 + k] = 0u; }
#endif
#ifndef PHMASK
#define PHMASK 0xFFFF
#endif
#define IN(k) (lo <= (k) && (k) < hi)
#define EN(b) ((PHMASK >> (b)) & 1)
#if TIMING
#define SEAM(k) do { if ((k) + 1 < hi) xcd_barrier(bar); } while (0)
#define TSTAMP(kind) do { if (F.c == 0 && threadIdx.x == 0) { const unsigned long long t_ = __builtin_amdgcn_s_memrealtime(); volatile LAS unsigned* T_ = (volatile LAS unsigned*)(F.lds + MISC_OFF + 256); \
        const unsigned long long p_ = ((unsigned long long)T_[1] << 32) | T_[0]; T_[2 + (kind)] += (unsigned)(t_ - p_); T_[0] = (unsigned)t_; T_[1] = (unsigned)(t_ >> 32); } } while (0)
#else
#define SEAM(k) do { if ((k) + 1 < hi || PROBE_DOUBLE) xcd_barrier(bar); } while (0)
#define TSTAMP(kind) do { } while (0)
#endif
#define WSP(T, off) ((T*)(ws + (off)))
#define PREP_GAP(nbusy, s0, s1) do { if (PREP_MODE == 1 && EN(1) && layer < 3 && F.c >= (nbusy)) { Ctx Fp = fresh(F); Fp.c = F.c - (nbusy); Fp.G = F.G - (nbusy); \
        prep_layer(Fp, kargs(), layer + 1, (s0), (s1), is_s5 ? 16 : 13, 0); __syncthreads(); } } while (0)

    if (EN(0) && IN(0)) for (int rep = 0; rep < NREP(0); ++rep) { KArgs ka = kargs(); unsigned char* ws = ka->ws;
        phase_init(fresh(F), ka->in[0], ka->in[1], ka->in[2], WSP(bf16_t, WS_HB), WSP(float, WS_SS), WSP(float, WS_SST), WSP(float, WS_ROPE), WSP(float, WS_ROPE + ROPE_HALF),
                   ka->in[8], ka->in[9], ka->in[10], ka->in[11], ka->in[12], WSP(float, WS_S5T));
        if (EN(1)) { xcd_barrier(bar); prep_layer(fresh(F), kargs(), 0, 0, 1, 1, 0); __syncthreads(); }
        SEAM(0); TSTAMP(0); }

    int nparts = 8;
    int ntp = 1;
    for (int sb = 0; sb < 12; ++sb) {
        const int layer = sb / 3, kind = sb - 3 * layer, pbase = 1 + 10 * layer, jm = layer >> 1;
        const bool is_s5 = (layer & 1) == 0;
        if (PREP_MODE == 0 && kind == 0 && layer > 0 && EN(1) && IN(pbase)) { prep_layer(fresh(F), kargs(), layer, 0, 1, 1, 0); __syncthreads(); SEAM(pbase); TSTAMP(1); }
        if (kind != 1) {
            const int p1 = pbase + (kind == 0 ? 1 : 8), p2 = p1 + 1;
            if (EN(2) && IN(p1)) for (int rep = 0; rep < NREP(2); ++rep) {
                KArgs ka = kargs(); unsigned char* ws = ka->ws;
                pg8::Gemm g{WSP(bf16_t, WS_HB), (bf16_t*)(ws + ((layer & 1) ? WS_W1 : WS_W) + (kind == 0 ? OW_WGU_A : OW_WGU_B)), D / 64, D / 64, D}; pg8::StaticOrder S; S.init(NREAL, 2 * DFF, F.G, F.c);
                EpiSwiGLU E{WSP(bf16_t, WS_ACT), WSP(float, WS_SS), (PROBE_EMPTY_EPI && rep + 1 < NREP(2)) ? -1 : nparts, F.lds};
                if (PROBE_EMPTY_EPI == 2 && rep + 1 < NREP(2)) pg8::gemm_phase<EpiSwiGLU, pg8::StaticOrder, 3>(F.lds, g, S, E); else
                pg8::gemm_phase<EpiSwiGLU, pg8::StaticOrder>(F.lds, g, S, E);

#if TAIL_DIRECT
                if (F.c * 2 < 352) { const Ctx Ft = fresh(F); tail_inv48(Ft, WSP(float, WS_SST), ntp);
                    TEpiSwiGLU TE{WSP(bf16_t, WS_ACT), (const LAS float*)(F.lds + TAIL_LDS_INV)};
                    tail_gemm<4>(Ft, g.A, D / 64, g.Bt, D / 64, D, 352, TMapPair(), TE); }
#else
                { pg8::SplitTailOrder T; T.init((2 * DFF) / 256, 4, 8, NREAL / 256, 1, F.c); pg8::Gemm g2 = g; g2.K = 512;
                  EpiSplit<EpiSwiGLU, 1> ES{E, WSP(float, WS_PART), (unsigned*)(ws + WS_CTL) + CW_TICK + (p1) * 1024, 4, MISC + 16};
                  pg8::gemm_phase<EpiSplit<EpiSwiGLU, 1>, pg8::SplitTailOrder, 1>(F.lds, g2, T, ES); }
#endif
                                if (rep + 1 == NREP(2)) { const int q0 = is_s5 ? (kind == 0 ? 0 : 13) : (kind == 0 ? 0 : 10); PREP_GAP(176, q0, q0 + 1); }
                SEAM(p1); TSTAMP(2);
            }
            if (EN(3) && IN(p2)) for (int rep = 0; rep < NREP(3); ++rep) {
                KArgs ka = kargs(); unsigned char* ws = ka->ws;
                pg8::Gemm g{WSP(bf16_t, WS_ACT), (bf16_t*)(ws + ((layer & 1) ? WS_W1 : WS_W) + (kind == 0 ? OW_WD_A : OW_WD_B)), DFF / 64, DFF / 64, DFF}; pg8::StaticOrder S; S.init(NREAL, D, F.G, F.c, 4);
                EpiResid E{WSP(bf16_t, WS_HB), WSP(float, WS_SS), (rep + 1 < NREP(3)) ? 0.0f : 0.5f, (LAS float*)(F.lds + RED_OFF)};
                pg8::gemm_phase<EpiResid, pg8::StaticOrder>(F.lds, g, S, E);

#if TAIL_DIRECT
                if (F.c < 64) { const Ctx Ft = fresh(F);
                    TEpiResid TE{WSP(bf16_t, WS_HB), WSP(float, WS_SST), E.scale};
                    tail_gemm<8>(Ft, g.A, DFF / 64, g.Bt, DFF / 64, DFF, 64, TMapPlain(), TE); }
#else
                { pg8::SplitTailOrder T; T.init(D / 256, 11, 8, NREAL / 256, 1, F.c); pg8::Gemm g2 = g; g2.K = 512;
                  EpiSplit<EpiResid, 1> ES{E, WSP(float, WS_PART), (unsigned*)(ws + WS_CTL) + CW_TICK + (p2) * 1024, 11, MISC + 16};
                  pg8::gemm_phase<EpiSplit<EpiResid, 1>, pg8::SplitTailOrder, 1>(F.lds, g2, T, ES); }
#endif
                                if (rep + 1 == NREP(3)) { const int q0 = is_s5 ? (kind == 0 ? 1 : 14) : (kind == 0 ? 1 : 11); PREP_GAP(88, q0, q0 + 2); }
                if (PREP_MODE == 2 && EN(1) && kind == 2 && layer < 3 && rep + 1 == NREP(3)) { prep_layer(fresh(F), kargs(), layer + 1, 0, 1, 1, 0); __syncthreads(); }
                SEAM(p2); TSTAMP(3);
            }
            nparts = 8; ntp = 64;
        } else if (is_s5) {
            if (EN(4) && IN(pbase + 3)) for (int rep = 0; rep < NREP(4); ++rep) { KArgs ka = kargs(); unsigned char* ws = ka->ws; phase_s5a(fresh(F), WSP(bf16_t, WS_HB), WSP(float, WS_SS), nparts, WSP(float, WS_SST), ntp, WSP(bf16_t, WS_ACT)); SEAM(pbase + 3); TSTAMP(4); }
            if (EN(5) && IN(pbase + 4)) for (int rep = 0; rep < NREP(5); ++rep) {
                KArgs ka = kargs(); unsigned char* ws = ka->ws;
                pg8::Gemm g{WSP(bf16_t, WS_ACT), (bf16_t*)(ws + ((layer & 1) ? WS_W1 : WS_W) + OW_WMIX + MIX_BMAT), 8, 4, 256}; pg8::BlockDiagOrder S; S.init(F.G, F.c);
                EpiSloc E{WSP(bf16_t, WS_R2)};
                pg8::gemm_phase<EpiSloc, pg8::BlockDiagOrder>(F.lds, g, S, E);
                SEAM(pbase + 4); TSTAMP(5);
            }
            if (EN(6) && IN(pbase + 5)) for (int rep = 0; rep < NREP(6); ++rep) { KArgs ka = kargs(); unsigned char* ws = ka->ws; phase_scan(fresh(F), WSP(unsigned, WS_R2), WSP(bf16_t, WS_ACT), WSP(float, WS_A16));
                if (PREP_MODE == 1 && EN(1) && layer < 3 && rep + 1 == NREP(6)) prep_layer(fresh(F), kargs(), layer + 1, 3, 11, 16, 3);
                SEAM(pbase + 5); TSTAMP(6); }
            if (EN(7) && IN(pbase + 6)) for (int rep = 0; rep < NREP(7); ++rep) {
                KArgs ka = kargs(); unsigned char* ws = ka->ws;
                pg8::Gemm g{WSP(bf16_t, WS_ACT), (bf16_t*)(ws + ((layer & 1) ? WS_W1 : WS_W) + OW_WMIX + MIX_WY), 8, 8, 512}; pg8::BlockDiagOrder S; S.init(F.G, F.c);
                EpiY E{WSP(bf16_t, WS_R2)};
                pg8::gemm_phase<EpiY, pg8::BlockDiagOrder>(F.lds, g, S, E);
                zero_pad_rows(fresh(F), WSP(bf16_t, WS_R2));
                SEAM(pbase + 6); TSTAMP(7);
            }
            if (EN(8) && IN(pbase + 7)) for (int rep = 0; rep < NREP(8); ++rep) {
                KArgs ka = kargs(); unsigned char* ws = ka->ws;
                pg8::Gemm g{WSP(bf16_t, WS_R2), (bf16_t*)(ws + ((layer & 1) ? WS_W1 : WS_W) + OW_WMIX + MIX_WGLU), D / 64, D / 64, D}; pg8::StaticOrder S; S.init(NREAL, 2 * D, F.G, F.c);
                EpiGLU E{WSP(bf16_t, WS_HB), WSP(float, WS_SS), (rep + 1 < NREP(8)) ? 0.0f : 1.0f, (LAS float*)(F.lds + RED_OFF)};
                pg8::gemm_phase<EpiGLU, pg8::StaticOrder>(F.lds, g, S, E);

#if TAIL_DIRECT
                if (F.c * 2 < 128) { const Ctx Ft = fresh(F);
                    TEpiGLU TE{WSP(bf16_t, WS_HB), WSP(float, WS_SST), E.scale};
                    tail_gemm<4>(Ft, g.A, D / 64, g.Bt, D / 64, D, 128, TMapPair(), TE); }
#else
                { pg8::SplitTailOrder T; T.init((2 * D) / 256, 4, 8, NREAL / 256, 1, F.c); pg8::Gemm g2 = g; g2.K = 512;
                  EpiSplit<EpiGLU, 1> ES{E, WSP(float, WS_PART), (unsigned*)(ws + WS_CTL) + CW_TICK + (pbase + 7) * 1024, 4, MISC + 16};
                  pg8::gemm_phase<EpiSplit<EpiGLU, 1>, pg8::SplitTailOrder, 1>(F.lds, g2, T, ES); }
#endif
                                if (rep + 1 == NREP(8)) PREP_GAP(64, 11, 13);
                SEAM(pbase + 7); TSTAMP(8);
            }
            nparts = 16; ntp = 128;
        } else {
            if (EN(9) && IN(pbase + 3)) for (int rep = 0; rep < NREP(9); ++rep) {
                { KArgs ka = kargs(); unsigned char* ws = ka->ws;
                  pg8::Gemm g{WSP(bf16_t, WS_HB), (bf16_t*)(ws + ((layer & 1) ? WS_W1 : WS_W) + OW_WMIX + MIX_WQK), D / 64, D / 64, D}; pg8::StaticOrder S; S.init(NREAL, QKLD, F.G, F.c);
                  EpiQK E{WSP(bf16_t, WS_ACT), WSP(float, WS_SS), nparts, WSP(float, WS_ROPE), WSP(float, WS_ROPE + ROPE_HALF), 0.08838834764831845f * LOG2E};
                  pg8::gemm_phase<EpiQK, pg8::StaticOrder>(F.lds, g, S, E);

#if TAIL_DIRECT
                  if (F.c * 2 < 80) { const Ctx Ft = fresh(F); tail_inv48(Ft, WSP(float, WS_SST), ntp);
                    TEpiQK TE{WSP(bf16_t, WS_ACT), (const LAS float*)(F.lds + TAIL_LDS_INV), WSP(float, WS_ROPE), WSP(float, WS_ROPE + ROPE_HALF), 0.08838834764831845f * LOG2E};
                    tail_gemm<4>(Ft, g.A, D / 64, g.Bt, D / 64, D, 80, TMapQK(), TE); }
#else
                { pg8::SplitTailOrder T; T.init(QKLD / 256, 4, 8, NREAL / 256, 1, F.c); pg8::Gemm g2 = g; g2.K = 512;
                  EpiSplit<EpiQK, 1> ES{E, WSP(float, WS_PART), (unsigned*)(ws + WS_CTL) + CW_TICK + (pbase + 3) * 1024, 4, MISC + 16};
                  pg8::gemm_phase<EpiSplit<EpiQK, 1>, pg8::SplitTailOrder, 1>(F.lds, g2, T, ES); }
#endif
                 }
                if (rep + 1 == NREP(9)) PREP_GAP(40, 3, 5);
                { KArgs ka = kargs(); unsigned char* ws = ka->ws;
                  pg8::Gemm g{(bf16_t*)(ws + ((layer & 1) ? WS_W1 : WS_W) + OW_WMIX + MIX_WVT), WSP(bf16_t, WS_HB), D / 64, D / 64, D}; pg8::StaticOrder S; S.init(512, NREAL, F.G, F.c);
                  EpiVt E{WSP(bf16_t, WS_VT), WSP(float, WS_SS), nparts};
                  pg8::gemm_phase<EpiVt, pg8::StaticOrder>(F.lds, g, S, E);

#if TAIL_DIRECT
                  if (F.c * 2 < 16) { const Ctx Ft = fresh(F); tail_inv48(Ft, WSP(float, WS_SST), ntp);
                    TEpiVt TE{WSP(bf16_t, WS_VT), (const LAS float*)(F.lds + TAIL_LDS_INV)};
                    tail_gemm<4>(Ft, g.Bt, D / 64, g.A, D / 64, D, 16, TMapPlain(), TE); }
#else
                { pg8::SplitTailOrder T; T.init(2, 4, 8, NREAL / 256, 2, F.c); pg8::Gemm g2 = g; g2.K = 512;
                  EpiSplit<EpiVt, 2> ES{E, WSP(float, WS_PART), (unsigned*)(ws + WS_CTL) + CW_TICK + (pbase + 6) * 1024, 4, MISC + 16};
                  pg8::gemm_phase<EpiSplit<EpiVt, 2>, pg8::SplitTailOrder, 2>(F.lds, g2, T, ES); }
#endif
                 }
                if (rep + 1 == NREP(9)) PREP_GAP(8, 5, 8);
                SEAM(pbase + 3); TSTAMP(9);
            }
            if (EN(10) && IN(pbase + 4)) for (int rep = 0; rep < NREP(10); ++rep) { KArgs ka = kargs(); unsigned char* ws = ka->ws;
                phase_attn(fresh(F), WSP(bf16_t, WS_ACT), WSP(bf16_t, WS_VT), WSP(bf16_t, WS_R2), ka->in[19] + jm * 16); zero_pad_rows(fresh(F), WSP(bf16_t, WS_R2)); SEAM(pbase + 4); TSTAMP(10); }
            if (EN(11) && IN(pbase + 5)) for (int rep = 0; rep < NREP(11); ++rep) {
                KArgs ka = kargs(); unsigned char* ws = ka->ws;
                pg8::Gemm g{WSP(bf16_t, WS_R2), (bf16_t*)(ws + ((layer & 1) ? WS_W1 : WS_W) + OW_WMIX + MIX_WO), D / 64, D / 64, D}; pg8::StaticOrder S; S.init(NREAL, D, F.G, F.c);
                EpiResid E{WSP(bf16_t, WS_HB), WSP(float, WS_SS), (rep + 1 < NREP(11)) ? 0.0f : 1.0f, (LAS float*)(F.lds + RED_OFF)};
                pg8::gemm_phase<EpiResid, pg8::StaticOrder>(F.lds, g, S, E);

#if TAIL_DIRECT
                if (F.c * 2 < 64) { const Ctx Ft = fresh(F);
                    TEpiResid TE{WSP(bf16_t, WS_HB), WSP(float, WS_SST), E.scale};
                    tail_gemm<4>(Ft, g.A, D / 64, g.Bt, D / 64, D, 64, TMapPlain(), TE); }
#else
                { pg8::SplitTailOrder T; T.init(D / 256, 4, 8, NREAL / 256, 1, F.c); pg8::Gemm g2 = g; g2.K = 512;
                  EpiSplit<EpiResid, 1> ES{E, WSP(float, WS_PART), (unsigned*)(ws + WS_CTL) + CW_TICK + (pbase + 5) * 1024, 4, MISC + 16};
                  pg8::gemm_phase<EpiSplit<EpiResid, 1>, pg8::SplitTailOrder, 1>(F.lds, g2, T, ES); }
#endif
                                if (rep + 1 == NREP(11)) PREP_GAP(32, 8, 10);
                SEAM(pbase + 5); TSTAMP(11);
            }
            nparts = 8; ntp = 64;
        }
    }
#if TIMING
    {
        KArgs ka = kargs(); unsigned char* ws = ka->ws; float* tv = WSP(float, WS_CTL + 900 * 1024);
        if (F.c == 0 && threadIdx.x == 0) { volatile LAS unsigned* T_ = (volatile LAS unsigned*)(F.lds + MISC_OFF + 256); float a = 0.f, b = 0.f;
            for (int k = 0; k < 16; ++k) { const float us = (float)T_[2 + k] * 0.01f; if ((TIMING_A >> k) & 1) a += us; if ((TIMING_B >> k) & 1) b += us; }
            tv[0] = a; tv[1] = b * TIMING_BSCALE; }
        xcd_barrier(bar);
        const float a = tv[0], b = tv[1]; float* out = ka->out;
        for (size_t e = (size_t)F.c * 512 + threadIdx.x; e < (size_t)NREAL * D; e += (size_t)F.G * 512) out[e] = (e == 0) ? b : a;
    }
#else
    if (EN(12) && IN(PH_FINAL)) for (int rep = 0; rep < NREP(12); ++rep) { KArgs ka = kargs(); unsigned char* ws = ka->ws; phase_final(fresh(F), WSP(bf16_t, WS_HB), WSP(float, WS_SS), nparts, ka->in[4], ka->out); }
#endif
#undef IN
#undef SEAM
#undef EN
#undef WSP
}

#ifndef N_LAUNCH_MODE
#define N_LAUNCH_MODE 0
#endif
extern "C" void kernel_launch(void* const* d_in, const int* in_sizes, int n_in, void* d_out, int out_size, void* d_ws, size_t ws_size, hipStream_t stream) {
    static int grid = 0;
    if (grid == 0) {
        if (n_in != 20 || ws_size < WS_END) { fprintf(stderr, "kernel_launch: need 20 inputs and %zu bytes of workspace (got %d, %zu)\n", (size_t)WS_END, n_in, ws_size); grid = -1; return; }
        int dev = 0, cus = 0, per_cu = 0;
        if (hipGetDevice(&dev) != hipSuccess || hipDeviceGetAttribute(&cus, hipDeviceAttributeMultiprocessorCount, dev) != hipSuccess) { grid = -1; return; }
        if (hipFuncSetAttribute((const void*)fwd_kernel, hipFuncAttributeMaxDynamicSharedMemorySize, LDS_BYTES) != hipSuccess) { fprintf(stderr, "kernel_launch: hipFuncSetAttribute failed\n"); grid = -1; return; }
        if (hipOccupancyMaxActiveBlocksPerMultiprocessor(&per_cu, (const void*)fwd_kernel, 512, LDS_BYTES) != hipSuccess || per_cu < 1) { fprintf(stderr, "kernel_launch: occupancy query says %d blocks per CU\n", per_cu); grid = -1; (void)hipGetLastError(); return; }
        grid = cus;
    }
    if (grid < 0) return;
    hipMemsetAsync((char*)d_ws + WS_CTL, 0, CTL_BYTES, stream);
    Args a{};
    for (int i = 0; i < 20; ++i) a.in[i] = (const float*)d_in[i];
    a.out = (float*)d_out; a.ws = (unsigned char*)d_ws; a.pad = 0;
#if N_LAUNCH_MODE == 0
    a.ph_lo = 0; a.ph_hi = PH_END; a.li = 0;
    hipLaunchKernelGGL(fwd_kernel, dim3(grid), dim3(512), LDS_BYTES, stream, a);
#else
    for (int p = 0; p < PH_END; ++p) { a.ph_lo = p; a.ph_hi = p + 1; a.li = p; hipLaunchKernelGGL(fwd_kernel, dim3(grid), dim3(512), LDS_BYTES, stream, a); }
#endif
}
```
